# Optimizing an MI355X kernel written in HIP

```python
import math
import jax, jax.numpy as jnp
from jax import lax
import numpy as np

D_MODEL = 1024
BATCH = 4
SEQ = 8192
DEPTH = 2

GRID_W = 64
CTX_LEN = 256
HEAD_DIM = 64
BLOCK = 128
ROPE_BASE = 10000.0
EPS = 1e-6
POOL_WIDTH = D_MODEL // 2
POOL_WINDOWS = (2, 4, 8, 16)
POOL_GROUPS = len(POOL_WINDOWS)
POOL_GROUP_DIM = POOL_WIDTH // POOL_GROUPS
SWA_Q_HEADS = D_MODEL // 128
SWA_KV_HEADS = SWA_Q_HEADS // 4
SWA_WINDOW = 128
DIFF_HEADS = D_MODEL // 256
DIFF_V_DIM = 2 * HEAD_DIM
D_FF = 4 * D_MODEL

IN_SIZES = (POOL_WIDTH,
            SWA_Q_HEADS * HEAD_DIM,
            SWA_KV_HEADS * HEAD_DIM,
            SWA_KV_HEADS * HEAD_DIM,
            DIFF_HEADS * 2 * HEAD_DIM,
            DIFF_HEADS * 2 * HEAD_DIM,
            DIFF_HEADS * DIFF_V_DIM,
            3 * D_MODEL)
IN_OFFSETS = tuple(int(o) for o in np.cumsum(IN_SIZES)[:-1])
D_IN = int(sum(IN_SIZES))

kernel_name = "hybrid_pool_swa_diffattn_prefix_dit"


def rms_norm(x, g):
    xf = x.astype(jnp.float32)
    y = xf * lax.rsqrt(jnp.mean(xf * xf, axis=-1, keepdims=True) + EPS)
    return (y * g.astype(jnp.float32)).astype(x.dtype)


def modulate(h, shift, scale):
    return h * (1 + scale) + shift


def axial_rope_tables(rows):
    row = jnp.repeat(jnp.arange(rows, dtype=jnp.float32), GRID_W)
    col = jnp.tile(jnp.arange(GRID_W, dtype=jnp.float32), rows)
    n_freq = HEAD_DIM // 4
    inv = ROPE_BASE ** (-jnp.arange(n_freq, dtype=jnp.float32) / n_freq)
    ang = jnp.concatenate([row[:, None] * inv, col[:, None] * inv], axis=-1)
    return jnp.cos(ang), jnp.sin(ang)


def apply_rope(x, cos, sin):
    x1, x2 = jnp.split(x.astype(jnp.float32), 2, axis=-1)
    c = cos[:, None, :]
    s = sin[:, None, :]
    return jnp.concatenate([x1 * c - x2 * s, x2 * c + x1 * s], axis=-1).astype(x.dtype)


def centred_mean_minus_self(u, window):
    n = u.shape[1]
    uf = u.astype(jnp.float32)
    cs = jnp.concatenate([jnp.zeros_like(uf[:, :1]), jnp.cumsum(uf, axis=1)], axis=1)
    t = jnp.arange(n)
    lo = jnp.clip(t - window // 2, 0, n)
    hi = jnp.clip(t + window // 2, 0, n)
    cnt = (hi - lo).astype(jnp.float32)[None, :, None]
    return ((cs[:, hi] - cs[:, lo]) / cnt - uf).astype(u.dtype)


def pool_mixer(u, w_pool, pool_scale):
    groups = jnp.split(u, POOL_GROUPS, axis=-1)
    pooled = jnp.stack([centred_mean_minus_self(g, w) for g, w in zip(groups, POOL_WINDOWS)], axis=-2)
    mixed = jnp.einsum('bngc,gcd->bngd', pooled, w_pool)
    return mixed.reshape(u.shape) * pool_scale


def softmax_with_sink(s, sink):
    m = jnp.maximum(jnp.max(s, axis=-1, keepdims=True), sink)
    e = jnp.exp(s - m)
    return e / (jnp.sum(e, axis=-1, keepdims=True) + jnp.exp(sink - m))


def windowed_gqa_latent(q, k, v, k_ctx, v_ctx, sink):
    b, n, hq, dh = q.shape
    hkv = k.shape[2]
    grp = hq // hkv
    nb = n // BLOCK
    scale = dh ** -0.5
    qb = q.reshape(b, nb, BLOCK, hkv, grp, dh)
    pad = jnp.zeros((b, BLOCK, hkv, dh), k.dtype)

    def band(t):
        tr = jnp.concatenate([pad, t, pad], axis=1).reshape(b, nb + 2, BLOCK, hkv, dh)
        return jnp.concatenate([tr[:, :-2], tr[:, 1:-1], tr[:, 2:]], axis=2)

    kb, vb = band(k), band(v)
    a = jnp.arange(BLOCK)[:, None]
    j = jnp.arange(3 * BLOCK)[None, :]
    kpos = jnp.arange(nb)[:, None, None] * BLOCK - BLOCK + j[None]
    valid = (jnp.abs(j - BLOCK - a) <= SWA_WINDOW)[None] & (kpos >= 0) & (kpos < n)
    s_loc = jnp.einsum('bnqhgd,bnkhd->bnhgqk', qb, kb, preferred_element_type=jnp.float32) * scale
    s_loc = jnp.where(valid[None, :, None, None], s_loc, -jnp.inf)
    s_ctx = jnp.einsum('bnqhgd,bkhd->bnhgqk', qb, k_ctx, preferred_element_type=jnp.float32) * scale
    p = softmax_with_sink(jnp.concatenate([s_loc, s_ctx], axis=-1),
                          sink.astype(jnp.float32).reshape(1, 1, hkv, grp, 1, 1)).astype(v.dtype)
    o = (jnp.einsum('bnhgqk,bnkhd->bnqhgd', p[..., :3 * BLOCK], vb)
         + jnp.einsum('bnhgqk,bkhd->bnqhgd', p[..., 3 * BLOCK:], v_ctx))
    return o.reshape(b, n, hq * dh)


def gqa_context(q, k, v, sink):
    b, m, hq, dh = q.shape
    hkv = k.shape[2]
    grp = hq // hkv
    qg = q.reshape(b, m, hkv, grp, dh)
    s = jnp.einsum('bqhgd,bkhd->bhgqk', qg, k, preferred_element_type=jnp.float32) * dh ** -0.5
    p = softmax_with_sink(s, sink.astype(jnp.float32).reshape(1, hkv, grp, 1, 1)).astype(v.dtype)
    return jnp.einsum('bhgqk,bkhd->bqhgd', p, v).reshape(b, m, hq * dh)


def diff_attn(q1, q2, k1, k2, v, lam):
    scale = q1.shape[-1] ** -0.5
    s1 = jnp.einsum('bqhd,bkhd->bhqk', q1, k1, preferred_element_type=jnp.float32) * scale
    s2 = jnp.einsum('bqhd,bkhd->bhqk', q2, k2, preferred_element_type=jnp.float32) * scale
    p = jax.nn.softmax(s1, axis=-1) - lam * jax.nn.softmax(s2, axis=-1)
    return jnp.einsum('bhqk,bkhd->bqhd', p.astype(v.dtype), v)


def diff_attention_latent(q1, q2, k1, k2, v, k1c, k2c, vc, lam):
    b, n, h, dh = q1.shape
    nb = n // BLOCK
    k1a = jnp.concatenate([k1, k1c], axis=1)
    k2a = jnp.concatenate([k2, k2c], axis=1)
    va = jnp.concatenate([v, vc], axis=1)

    def to_blocks(t):
        return jnp.moveaxis(t.reshape(b, nb, BLOCK, h, dh), 1, 0)

    o = lax.map(lambda qs: diff_attn(qs[0], qs[1], k1a, k2a, va, lam), (to_blocks(q1), to_blocks(q2)))
    return jnp.moveaxis(o, 0, 1).reshape(b, n, h, DIFF_V_DIM)


def diff_head_out(o, subln, lam_init):
    b, m = o.shape[:2]
    return (rms_norm(o, subln) * (1 - lam_init)).reshape(b, m, DIFF_HEADS * DIFF_V_DIM)


def project_streams(z, swa_qn, swa_kn, diff_qn, diff_kn, cos, sin):
    b, m = z.shape[:2]
    u, qs, ks, vs, qd, kd, vd, g = jnp.split(z, IN_OFFSETS, axis=-1)
    qs = rms_norm(qs.reshape(b, m, SWA_Q_HEADS, HEAD_DIM), swa_qn)
    ks = rms_norm(ks.reshape(b, m, SWA_KV_HEADS, HEAD_DIM), swa_kn)
    qd = rms_norm(qd.reshape(b, m, 2 * DIFF_HEADS, HEAD_DIM), diff_qn)
    kd = rms_norm(kd.reshape(b, m, 2 * DIFF_HEADS, HEAD_DIM), diff_kn)
    if cos is not None:
        qs, ks, qd, kd = [apply_rope(t, cos, sin) for t in (qs, ks, qd, kd)]
    qd = qd.reshape(b, m, DIFF_HEADS, 2, HEAD_DIM)
    kd = kd.reshape(b, m, DIFF_HEADS, 2, HEAD_DIM)
    vs = vs.reshape(b, m, SWA_KV_HEADS, HEAD_DIM)
    vd = vd.reshape(b, m, DIFF_HEADS, DIFF_V_DIM)
    gates = jax.nn.sigmoid(g.astype(jnp.float32)).astype(z.dtype)
    return (u, qs, ks, vs, qd[..., 0, :], qd[..., 1, :], kd[..., 0, :], kd[..., 1, :], vd, gates)


def merge_branches(y_pool, y_swa, y_diff, gates, w_bp, w_bs, w_bd, w_out):
    g = gates.reshape(gates.shape[:-1] + (3, D_MODEL))
    merged = (g[..., 0, :] * (y_pool @ w_bp) + g[..., 1, :] * (y_swa @ w_bs)
              + g[..., 2, :] * (y_diff @ w_bd))
    return merged @ w_out


def sq_relu_mlp(h, w1, w2):
    return jnp.square(jax.nn.relu(h @ w1)) @ w2


def setup_inputs(seed: int = 0) -> dict:
    key = jax.random.key(seed)
    ks = jax.random.split(key, 24)
    f = jnp.float32
    nrm = lambda k, shape, s: jax.random.normal(k, shape, f) * s
    gain = lambda k, shape: 1.0 + 0.02 * jax.random.normal(k, shape, f)
    return {
        'x': nrm(ks[0], (BATCH, SEQ, D_MODEL), 1.0),
        'c': nrm(ks[1], (BATCH, D_MODEL), 1.0),
        'ctx': nrm(ks[2], (BATCH, CTX_LEN, D_MODEL), 1.0),
        'c_ctx': nrm(ks[3], (D_MODEL,), 1.0),
        'w_ada': nrm(ks[4], (DEPTH, D_MODEL, 6 * D_MODEL), 0.5 * D_MODEL ** -0.5),
        'b_ada': nrm(ks[5], (DEPTH, 6 * D_MODEL), 0.01),
        'norm1': gain(ks[6], (DEPTH, D_MODEL)),
        'norm2': gain(ks[7], (DEPTH, D_MODEL)),
        'w_in': nrm(ks[8], (DEPTH, D_MODEL, D_IN), D_MODEL ** -0.5),
        'w_pool': nrm(ks[9], (DEPTH, POOL_GROUPS, POOL_GROUP_DIM, POOL_GROUP_DIM), POOL_GROUP_DIM ** -0.5),
        'pool_scale': gain(ks[10], (DEPTH, POOL_WIDTH)),
        'swa_q_norm': gain(ks[11], (DEPTH, HEAD_DIM)),
        'swa_k_norm': gain(ks[12], (DEPTH, HEAD_DIM)),
        'swa_sink': nrm(ks[13], (DEPTH, SWA_Q_HEADS), 0.5),
        'diff_q_norm': gain(ks[14], (DEPTH, HEAD_DIM)),
        'diff_k_norm': gain(ks[15], (DEPTH, HEAD_DIM)),
        'diff_lambda': nrm(ks[16], (DEPTH, 4, HEAD_DIM), 0.1),
        'diff_subln': gain(ks[17], (DEPTH, DIFF_V_DIM)),
        'w_br_pool': nrm(ks[18], (DEPTH, POOL_WIDTH, D_MODEL), POOL_WIDTH ** -0.5),
        'w_br_swa': nrm(ks[19], (DEPTH, SWA_Q_HEADS * HEAD_DIM, D_MODEL), (SWA_Q_HEADS * HEAD_DIM) ** -0.5),
        'w_br_diff': nrm(ks[20], (DEPTH, DIFF_HEADS * DIFF_V_DIM, D_MODEL), (DIFF_HEADS * DIFF_V_DIM) ** -0.5),
        'w_out': nrm(ks[21], (DEPTH, D_MODEL, D_MODEL), D_MODEL ** -0.5),
        'w_ff1': nrm(ks[22], (DEPTH, D_MODEL, D_FF), D_MODEL ** -0.5),
        'w_ff2': nrm(ks[23], (DEPTH, D_FF, D_MODEL), D_FF ** -0.5),
    }


def reference(x, c, ctx, c_ctx, w_ada, b_ada, norm1, norm2, w_in, w_pool, pool_scale,
              swa_q_norm, swa_k_norm, swa_sink, diff_q_norm, diff_k_norm, diff_lambda,
              diff_subln, w_br_pool, w_br_swa, w_br_diff, w_out, w_ff1, w_ff2):
    n = x.shape[1]
    rows = n // GRID_W
    cos, sin = axial_rope_tables(rows)
    c_act = jax.nn.silu(c)
    cc_act = jax.nn.silu(c_ctx)
    xc = ctx
    for l in range(DEPTH):
        lam_init = 0.8 - 0.6 * math.exp(-0.3 * l)
        lam = (jnp.exp(jnp.sum(diff_lambda[l, 0] * diff_lambda[l, 1]))
               - jnp.exp(jnp.sum(diff_lambda[l, 2] * diff_lambda[l, 3])) + lam_init)
        mod = c_act @ w_ada[l] + b_ada[l]
        mod_c = cc_act @ w_ada[l] + b_ada[l]
        sh1, sc1, g1, sh2, sc2, g2 = [m[:, None, :] for m in jnp.split(mod, 6, axis=-1)]
        sh1c, sc1c, g1c, sh2c, sc2c, g2c = jnp.split(mod_c, 6, axis=-1)

        hc = modulate(rms_norm(xc, norm1[l]), sh1c, sc1c)
        (uc, qsc, ksc, vsc, q1c, q2c, k1c, k2c, vdc, gc) = project_streams(
            hc @ w_in[l], swa_q_norm[l], swa_k_norm[l], diff_q_norm[l], diff_k_norm[l], None, None)

        h = modulate(rms_norm(x, norm1[l]), sh1, sc1)
        (u, qs, ks_, vs, q1, q2, k1, k2, vd, gl) = project_streams(
            h @ w_in[l], swa_q_norm[l], swa_k_norm[l], diff_q_norm[l], diff_k_norm[l], cos, sin)
        y_pool = pool_mixer(u, w_pool[l], pool_scale[l])
        y_swa = windowed_gqa_latent(qs, ks_, vs, ksc, vsc, swa_sink[l])
        y_diff = diff_head_out(diff_attention_latent(q1, q2, k1, k2, vd, k1c, k2c, vdc, lam),
                               diff_subln[l], lam_init)
        x = x + g1 * merge_branches(y_pool, y_swa, y_diff, gl,
                                    w_br_pool[l], w_br_swa[l], w_br_diff[l], w_out[l])
        x = x + g2 * sq_relu_mlp(modulate(rms_norm(x, norm2[l]), sh2, sc2), w_ff1[l], w_ff2[l])

        if l < DEPTH - 1:
            yc_pool = pool_mixer(uc, w_pool[l], pool_scale[l])
            yc_swa = gqa_context(qsc, ksc, vsc, swa_sink[l])
            yc_diff = diff_head_out(diff_attn(q1c, q2c, k1c, k2c, vdc, lam), diff_subln[l], lam_init)
            xc = xc + g1c * merge_branches(yc_pool, yc_swa, yc_diff, gc,
                                           w_br_pool[l], w_br_swa[l], w_br_diff[l], w_out[l])
            xc = xc + g2c * sq_relu_mlp(modulate(rms_norm(xc, norm2[l]), sh2c, sc2c), w_ff1[l], w_ff2[l])
    return x
```

```cpp
#include <hip/hip_runtime.h>
#include <hip/hip_cooperative_groups.h>
#include <cstdio>
#include <cstdint>
#include <type_traits>
namespace cg = cooperative_groups;

constexpr int NB = 4, T = 8192, D = 1024, NL = 2, CT = 256, FF = 4096;
constexpr int MLAT = NB * T, MCTX = NB * CT, MTOT = MLAT + MCTX;
constexpr int DIN = 5888, N1 = 2816, NG = 3072, YW = 1536;
constexpr int C_U = 0, C_QS = 512, C_KS = 1024, C_VS = 1152, C_QD = 1280, C_KD = 1792, C_VD = 2304;
constexpr float EPS = 1e-6f;
constexpr float QSCALE = 0.125f * 1.4426950408889634f;
constexpr float LOG2E = 1.4426950408889634f;

constexpr size_t MiB = 1u << 20;
constexpr size_t WS_CTL = 0;
constexpr size_t WS_MOD = 1 * MiB;
constexpr size_t WS_LAM = 1 * MiB + 512 * 1024;
constexpr size_t WS_W = 2 * MiB, WL_STRIDE = 33 * MiB;
constexpr size_t WO_IN1 = 0, WO_G = 5 * MiB + 512 * 1024, WO_BR = 11 * MiB + 512 * 1024, WO_OUT = 14 * MiB + 512 * 1024, WO_1 = 16 * MiB + 512 * 1024, WO_2 = 24 * MiB + 512 * 1024;
constexpr size_t WS_XC = 68 * MiB;
constexpr size_t WS_XN = 72 * MiB;
constexpr size_t WS_Y = 138 * MiB;
constexpr size_t WS_BIG = 237 * MiB;
constexpr size_t BO_Z1 = 0, BO_VT = 182 * MiB, BO_G = 0, BO_MG = 198 * MiB, BO_H = 0;
constexpr size_t VT_VS_LAT = 0, VT_VD_LAT = 8 * MiB, VT_VS_CTX = 40 * MiB, VT_VD_CTX = 40 * MiB + 256 * 1024;
constexpr size_t WS_END = 501 * MiB;
static_assert((size_t)MTOT * N1 * 2 <= BO_VT && BO_VT + 42 * MiB <= 264 * MiB && (size_t)MTOT * NG * 2 <= BO_MG && BO_MG + (size_t)MTOT * D * 2 <= 264 * MiB && (size_t)MTOT * FF * 2 <= 264 * MiB, "BIG map");
static_assert(WS_XN + (size_t)MTOT * D * 2 <= WS_Y && WS_Y + (size_t)MTOT * YW * 2 <= WS_BIG && WS_BIG + 264 * MiB <= WS_END, "ws map");

constexpr int LDS_BYTES = 147456;
constexpr int NWAVES = 8;

#define LAS __attribute__((address_space(3)))
typedef unsigned short bf16;
typedef unsigned v4u __attribute__((ext_vector_type(4)));
typedef unsigned v2u __attribute__((ext_vector_type(2)));
typedef float f32x4 __attribute__((ext_vector_type(4)));
typedef float f32x16 __attribute__((ext_vector_type(16)));
typedef short bf16x8 __attribute__((ext_vector_type(8)));
typedef short s16x4 __attribute__((ext_vector_type(4)));

typedef float f32x2_t __attribute__((ext_vector_type(2))); typedef __bf16 bf16x2_t __attribute__((ext_vector_type(2)));
__device__ __forceinline__ unsigned cvt_pk_bf16(float lo, float hi) { f32x2_t v = {lo, hi}; bf16x2_t b = __builtin_convertvector(v, bf16x2_t); return __builtin_bit_cast(unsigned, b); }
__device__ __forceinline__ float bf_lo(unsigned u) { return __builtin_bit_cast(float, u << 16); }
__device__ __forceinline__ float bf_hi(unsigned u) { return __builtin_bit_cast(float, u & 0xffff0000u); }
__device__ __forceinline__ float bf1(bf16 h) { return __builtin_bit_cast(float, (unsigned)h << 16); }
template <int X> __device__ __forceinline__ float swz_xor(float v) { return __builtin_bit_cast(float, __builtin_amdgcn_ds_swizzle(__builtin_bit_cast(int, v), (X << 10) | 0x1f)); }
__device__ __forceinline__ float xsum32(float v) { const unsigned u = __builtin_bit_cast(unsigned, v); auto rr = __builtin_amdgcn_permlane32_swap(u, u, false, false); return __builtin_bit_cast(float, (unsigned)rr[0]) + __builtin_bit_cast(float, (unsigned)rr[1]); }
__device__ __forceinline__ float xmax32(float v) { const unsigned u = __builtin_bit_cast(unsigned, v); auto rr = __builtin_amdgcn_permlane32_swap(u, u, false, false); return fmaxf(__builtin_bit_cast(float, (unsigned)rr[0]), __builtin_bit_cast(float, (unsigned)rr[1])); }
__device__ __forceinline__ float xget32(float v, bool lower_half) { const unsigned u = __builtin_bit_cast(unsigned, v); auto rr = __builtin_amdgcn_permlane32_swap(u, u, false, false); return lower_half ? __builtin_bit_cast(float, (unsigned)rr[1]) : __builtin_bit_cast(float, (unsigned)rr[0]); }
__device__ __forceinline__ float wave_sum(float v) { v += swz_xor<1>(v); v += swz_xor<2>(v); v += swz_xor<4>(v); v += swz_xor<8>(v); v += swz_xor<16>(v); return xsum32(v); }
__device__ __forceinline__ float wave_max(float v) { v = fmaxf(v, swz_xor<1>(v)); v = fmaxf(v, swz_xor<2>(v)); v = fmaxf(v, swz_xor<4>(v)); v = fmaxf(v, swz_xor<8>(v)); v = fmaxf(v, swz_xor<16>(v)); return xmax32(v); }

namespace pg8 {
#define PG8_LAS __attribute__((address_space(3)))
typedef unsigned short bf16_t;
typedef short bf16x8 __attribute__((ext_vector_type(8)));
typedef float f32x4 __attribute__((ext_vector_type(4)));
typedef unsigned u32x4 __attribute__((ext_vector_type(4)));
constexpr int BM = 256, BK = 64, HALF = 128, HTB = HALF * BK * 2  , STAGE_BYTES = 8 * HTB, NXCD = 8, WGM = 8;

__host__ __device__ __forceinline__ int lds_byte(int r, int c) { const int st = (r >> 4) * 2 + (c >> 5), rr = r & 15, cc = c & 31, ob = rr * 64 + cc * 2; return st * 1024 + (ob ^ (((ob >> 9) & 1) << 5)); }
__host__ __device__ __forceinline__ void stage_rc(int b, int& R, int& C) { const int st = b / 1024, sb = b % 1024, swz = sb ^ (((sb >> 9) & 1) << 5); R = (st >> 1) * 16 + swz / 64; C = (st & 1) * 32 + (swz % 64) / 2; }
__host__ __device__ __forceinline__ int perm32(int rho) { const int n = rho >> 4, i = rho & 15; return 8 * (i >> 2) + 4 * n + (i & 3); }

struct Unit { int pm, pn; };
struct Gemm { const bf16_t* A; const bf16_t* Bt; int M, N, K, lda, ldb, agrp, agstride; };

struct StaticOrder {
    int nM, nN, nwg, G, c;
    __host__ __device__ void init(int M, int N, int G_, int c_) { nM = M / BM; nN = N / BM; nwg = nM * nN; G = G_; c = c_; }
    __host__ __device__ bool next(int i, Unit& u) const {
        const long L = (long)i * G + c; if (L >= nwg) return false;
        int wgid = (int)L; { const int q = nwg / NXCD, r = nwg % NXCD, xcd = wgid % NXCD, off = wgid / NXCD; wgid = (xcd < r ? xcd * (q + 1) : r * (q + 1) + (xcd - r) * q) + off; }
        const int nig = WGM * nN, gid = wgid / nig, fm = gid * WGM, gsz = (nM - fm) < WGM ? (nM - fm) : WGM;
        u.pm = fm + ((wgid % nig) % gsz); u.pn = (wgid % nig) / gsz; return true;
    }
    __device__ __forceinline__ void a_ready(const Unit&) const {}
    __device__ __forceinline__ void done(const Unit&) const {}
};


__device__ __forceinline__ float act_sigmoid(float v) { return __builtin_amdgcn_rcpf(1.0f + __builtin_amdgcn_exp2f(-v * 1.4426950408889634f)); }
template <int ACT  > struct EpiStore {
    static constexpr bool PERM = true, AFTER_DRAIN = false;
    bf16_t* O; int ldc;
    __device__ __forceinline__ void operator()(const f32x4 (&acc)[2][2][4][2], const Unit& u, int wr, int wc, int fr, int fq) const {
        const int row0 = u.pm * BM + wr * 64 + fr, col0 = u.pn * BM + wc * 32 + 8 * fq;
#pragma unroll
        for (int ai = 0; ai < 2; ++ai)
#pragma unroll
            for (int m = 0; m < 4; ++m) { bf16_t* rowp = O + (size_t)(row0 + ai * HALF + m * 16) * ldc + col0;
#pragma unroll
                for (int bj = 0; bj < 2; ++bj) { f32x4 v0 = acc[ai][bj][m][0], v1 = acc[ai][bj][m][1];
                    if (ACT == 1) {
#pragma unroll
                        for (int e = 0; e < 4; ++e) { v0[e] = act_sigmoid(v0[e]); v1[e] = act_sigmoid(v1[e]); } }
                    if (ACT == 2) {
#pragma unroll
                        for (int e = 0; e < 4; ++e) { const float a = fmaxf(v0[e], 0.f), b = fmaxf(v1[e], 0.f); v0[e] = a * a; v1[e] = b * b; } }
                    u32x4 w; w.x = cvt_pk_bf16(v0[0], v0[1]); w.y = cvt_pk_bf16(v0[2], v0[3]); w.z = cvt_pk_bf16(v1[0], v1[1]); w.w = cvt_pk_bf16(v1[2], v1[3]);
                    *(u32x4*)(rowp + bj * HALF) = w; } }
    }
};
struct EpiGate {
    static constexpr bool PERM = true, AFTER_DRAIN = false;
    bf16_t* G; int ldc;
    __device__ __forceinline__ void operator()(const f32x4 (&acc)[2][2][4][2], const Unit& u, int wr, int wc, int fr, int fq) const {
        const int row0 = u.pm * BM + wr * 64 + fr, col0 = u.pn * BM + wc * 32 + 8 * fq;
#pragma unroll
        for (int ai = 0; ai < 2; ++ai)
#pragma unroll
            for (int m = 0; m < 4; ++m) { bf16_t* rowp = G + (size_t)(row0 + ai * HALF + m * 16) * ldc + col0;
#pragma unroll
                for (int bj = 0; bj < 2; ++bj) { const f32x4 v0 = acc[ai][bj][m][0], v1 = acc[ai][bj][m][1];
                    const u32x4 g = *(const u32x4*)(rowp + bj * HALF);
                    u32x4 w; w.x = cvt_pk_bf16(v0[0] * bf_lo(g.x), v0[1] * bf_hi(g.x)); w.y = cvt_pk_bf16(v0[2] * bf_lo(g.y), v0[3] * bf_hi(g.y));
                    w.z = cvt_pk_bf16(v1[0] * bf_lo(g.z), v1[1] * bf_hi(g.z)); w.w = cvt_pk_bf16(v1[2] * bf_lo(g.w), v1[3] * bf_hi(g.w));
                    *(u32x4*)(rowp + bj * HALF) = w; } }
    }
};
struct EpiResid {
    static constexpr bool PERM = true, AFTER_DRAIN = false;
    const float* res_lat; const float* res_ctx; float* out_lat; float* out_ctx; const float* modg;
    __device__ __forceinline__ void operator()(const f32x4 (&acc)[2][2][4][2], const Unit& u, int wr, int wc, int fr, int fq) const {
        const int r0 = u.pm * BM; const bool lat = r0 < MLAT;
        const float* res = lat ? res_lat : res_ctx - (size_t)MLAT * D; float* out = lat ? out_lat : out_ctx - (size_t)MLAT * D;
        const int bidx = lat ? (r0 / T) : NB;
        const int row0 = r0 + wr * 64 + fr, col0 = u.pn * BM + wc * 32 + 8 * fq;
        f32x4 gv[2][2];
#pragma unroll
        for (int bj = 0; bj < 2; ++bj)
#pragma unroll
            for (int n = 0; n < 2; ++n) gv[bj][n] = *(const f32x4*)(modg + (size_t)bidx * 6144 + col0 + bj * HALF + 4 * n);
#pragma unroll
        for (int ai = 0; ai < 2; ++ai)
#pragma unroll
            for (int m = 0; m < 4; ++m) { const size_t ro = (size_t)(row0 + ai * HALF + m * 16) * D + col0;
#pragma unroll
                for (int bj = 0; bj < 2; ++bj)
#pragma unroll
                    for (int n = 0; n < 2; ++n) { const f32x4 r = *(const f32x4*)(res + ro + bj * HALF + 4 * n);
                        *(f32x4*)(out + ro + bj * HALF + 4 * n) = r + gv[bj][n] * acc[ai][bj][m][n]; } }
    }
};

template <class Epi, class Sched, bool ALIGN_EPI = false, bool SP2 = false>
__device__ __forceinline__ void gemm_phase(PG8_LAS unsigned char* lds, const int tid, const Gemm g, const Sched& S, const Epi& E) {
    const int wid = __builtin_amdgcn_readfirstlane(tid >> 6), lane = tid & 63, wr = wid >> 2, wc = wid & 3, fr = lane & 15, fq = lane >> 4;
    const int K = g.K, nt = K / BK;
    unsigned voffA[2], voffB[2];
#pragma unroll
    for (int i = 0; i < 2; ++i) { int R, C; stage_rc(tid * 16 + i * 8192, R, C); const int Rb = Epi::PERM ? ((R & ~31) + perm32(R & 31)) : R;
        voffA[i] = (unsigned)(R * g.lda + C) * 2u; voffB[i] = (unsigned)(Rb * g.ldb + C) * 2u; }
    const size_t kstep = (size_t)(BK * 2);
    const size_t hstepA = (size_t)HALF * g.lda * 2, hstepB = (size_t)HALF * g.ldb * 2;
    const size_t tstepA = 2 * hstepA, tstepB = 2 * hstepB;
#define PG8_ABASE(u) ((const char*)g.A + (size_t)(u).pm * tstepA + (g.agrp ? (size_t)((u).pn / g.agrp) * (size_t)g.agstride * 2 : (size_t)0))
#define PG8_BBASE(u) ((const char*)g.Bt + (size_t)(u).pn * tstepB)
    const unsigned ldsw = (unsigned)wid * 1024u;
    const int aoff = lds_byte(wr * 64 + fr, fq * 8), boff = lds_byte(wc * 32 + fr, fq * 8);
#define PG8_SA(b, h) (((b) * 2 + (h)) * HTB)
#define PG8_SB(b, h) ((4 + (b) * 2 + (h)) * HTB)
#define PG8_STAGE(bufoff, gbase, voff) do { _Pragma("unroll") for (int _i = 0; _i < 2; ++_i) \
        __builtin_amdgcn_global_load_lds((const unsigned*)((const char*)(gbase) + (voff)[_i]), (PG8_LAS unsigned*)(lds + (bufoff) + ldsw + _i * 8192), 16, 0, 0); } while (0)
#define PG8_LDA(dst, b, h) do { _Pragma("unroll") for (int m = 0; m < 4; ++m) _Pragma("unroll") for (int k = 0; k < 2; ++k) dst[m][k] = *(const PG8_LAS bf16x8*)(lds + PG8_SA(b, h) + aoff + m * 2048 + k * 1024); } while (0)
#define PG8_LDB(dst, b, h) do { _Pragma("unroll") for (int n = 0; n < 2; ++n) _Pragma("unroll") for (int k = 0; k < 2; ++k) dst[n][k] = *(const PG8_LAS bf16x8*)(lds + PG8_SB(b, h) + boff + n * 2048 + k * 1024); } while (0)
#define PG8_MMA(ai, bj, At, Bt) do { __builtin_amdgcn_s_setprio(1); _Pragma("unroll") for (int m = 0; m < 4; ++m) _Pragma("unroll") for (int n = 0; n < 2; ++n) _Pragma("unroll") for (int k = 0; k < 2; ++k) \
        acc[ai][bj][m][n] = __builtin_amdgcn_mfma_f32_16x16x32_bf16(Bt[n][k], At[m][k], acc[ai][bj][m][n], 0, 0, 0); __builtin_amdgcn_s_setprio(0); } while (0)
#define PG8_WAIT_V(n) asm volatile("s_waitcnt vmcnt(" #n ")" ::: "memory")
#define PG8_WAIT_L(n) asm volatile("s_waitcnt lgkmcnt(" #n ")" ::: "memory")
#define PG8_BAR __builtin_amdgcn_s_barrier()
#define PG8_SCHED __builtin_amdgcn_sched_barrier(0)
    Unit cur, nxt; int ui = 0;
    if (!S.next(0, cur)) return;
    f32x4 acc[2][2][4][2];
#pragma unroll
    for (int a = 0; a < 2; ++a)
#pragma unroll
        for (int b = 0; b < 2; ++b)
#pragma unroll
            for (int m = 0; m < 4; ++m)
#pragma unroll
                for (int n = 0; n < 2; ++n) acc[a][b][m][n] = (f32x4){0.f, 0.f, 0.f, 0.f};
    bf16x8 At[4][2], B0[2][2], B1[2][2];
    const char* cA = PG8_ABASE(cur); const char* cB = PG8_BBASE(cur);
    S.a_ready(cur);
    if constexpr (SP2) {
        PG8_STAGE(PG8_SB(0, 0), cB, voffB); PG8_STAGE(PG8_SB(0, 1), cB + hstepB, voffB); PG8_STAGE(PG8_SA(0, 0), cA, voffA); PG8_STAGE(PG8_SA(0, 1), cA + hstepA, voffA);
        if (wr == 1) PG8_BAR;
        PG8_WAIT_V(2); PG8_BAR;
        PG8_STAGE(PG8_SB(1, 0), cB + kstep, voffB); PG8_STAGE(PG8_SA(1, 0), cA + kstep, voffA); PG8_STAGE(PG8_SB(1, 1), cB + hstepB + kstep, voffB);
        PG8_WAIT_V(6); PG8_BAR;
    } else {
        PG8_STAGE(PG8_SB(0, 0), cB, voffB); PG8_STAGE(PG8_SA(0, 0), cA, voffA); PG8_STAGE(PG8_SB(0, 1), cB + hstepB, voffB); PG8_STAGE(PG8_SA(0, 1), cA + hstepA, voffA);
        if (wr == 1) PG8_BAR;
        PG8_WAIT_V(4); PG8_BAR;
        PG8_STAGE(PG8_SB(1, 0), cB + kstep, voffB); PG8_STAGE(PG8_SA(1, 0), cA + kstep, voffA); PG8_STAGE(PG8_SB(1, 1), cB + hstepB + kstep, voffB);
        PG8_WAIT_V(6); PG8_BAR;
    }
    for (;;) {
        const bool has_next = S.next(ui + 1, nxt);
        const char* nA = has_next ? PG8_ABASE(nxt) : cA; const char* nB = has_next ? PG8_BBASE(nxt) : cB;
        for (int t = 0; t < nt; t += 2) {
            const bool last = (t == nt - 2);
            const char* a1 = cA + (size_t)(t + 1) * kstep;
            const char* a2 = last ? nA : cA + (size_t)(t + 2) * kstep; const char* b2 = last ? nB : cB + (size_t)(t + 2) * kstep;
            const char* a3 = a2 + kstep; const char* b3 = b2 + kstep;
            if (last && has_next) S.a_ready(nxt);
            if constexpr (SP2) {
            PG8_LDB(B0, 0, 0); PG8_LDB(B1, 0, 1); PG8_SCHED; PG8_LDA(At, 0, 0); PG8_STAGE(PG8_SA(1, 1), a1 + hstepA, voffA);
            PG8_WAIT_V(8); PG8_WAIT_L(0); PG8_BAR; PG8_MMA(0, 0, At, B0); PG8_MMA(0, 1, At, B1); PG8_BAR; PG8_SCHED;
            PG8_LDA(At, 0, 1); PG8_STAGE(PG8_SB(0, 0), b2, voffB); PG8_STAGE(PG8_SB(0, 1), b2 + hstepB, voffB); PG8_STAGE(PG8_SA(0, 0), a2, voffA);
            PG8_WAIT_V(8); PG8_WAIT_L(0); PG8_BAR; PG8_MMA(1, 0, At, B0); PG8_MMA(1, 1, At, B1); PG8_BAR; PG8_SCHED;
            PG8_LDB(B0, 1, 0); PG8_LDB(B1, 1, 1); PG8_SCHED; PG8_LDA(At, 1, 0); PG8_STAGE(PG8_SA(0, 1), a2 + hstepA, voffA);
            PG8_WAIT_V(8); PG8_WAIT_L(0); PG8_BAR; PG8_MMA(0, 0, At, B0); PG8_MMA(0, 1, At, B1); PG8_BAR; PG8_SCHED;
            PG8_LDA(At, 1, 1); PG8_STAGE(PG8_SB(1, 0), b3, voffB); PG8_STAGE(PG8_SB(1, 1), b3 + hstepB, voffB); PG8_STAGE(PG8_SA(1, 0), a3, voffA);
            PG8_WAIT_V(8); PG8_WAIT_L(0); PG8_BAR; PG8_MMA(1, 0, At, B0); PG8_MMA(1, 1, At, B1); PG8_BAR; PG8_SCHED;
            } else {
            PG8_LDB(B0, 0, 0); PG8_SCHED; PG8_LDA(At, 0, 0); PG8_STAGE(PG8_SA(1, 1), a1 + hstepA, voffA);
            PG8_WAIT_L(8); PG8_BAR; PG8_WAIT_L(0); PG8_MMA(0, 0, At, B0); PG8_BAR; PG8_SCHED;
            PG8_LDB(B1, 0, 1); PG8_STAGE(PG8_SB(0, 0), b2, voffB);
            PG8_BAR; PG8_WAIT_L(0); PG8_MMA(0, 1, At, B1); PG8_BAR;
            PG8_LDA(At, 0, 1); PG8_STAGE(PG8_SA(0, 0), a2, voffA);
            PG8_BAR; PG8_WAIT_L(0); PG8_MMA(1, 0, At, B0); PG8_BAR; PG8_SCHED;
            PG8_STAGE(PG8_SB(0, 1), b2 + hstepB, voffB);
            PG8_WAIT_V(6); PG8_BAR; PG8_MMA(1, 1, At, B1); PG8_BAR;
            PG8_LDB(B0, 1, 0); PG8_SCHED; PG8_LDA(At, 1, 0); PG8_STAGE(PG8_SA(0, 1), a2 + hstepA, voffA);
            PG8_WAIT_L(8); PG8_BAR; PG8_WAIT_L(0); PG8_MMA(0, 0, At, B0); PG8_BAR; PG8_SCHED;
            PG8_LDB(B1, 1, 1); PG8_STAGE(PG8_SB(1, 0), b3, voffB);
            PG8_BAR; PG8_WAIT_L(0); PG8_MMA(0, 1, At, B1); PG8_BAR;
            PG8_LDA(At, 1, 1); PG8_STAGE(PG8_SA(1, 0), a3, voffA);
            PG8_BAR; PG8_WAIT_L(0); PG8_MMA(1, 0, At, B0); PG8_BAR; PG8_SCHED;
            PG8_STAGE(PG8_SB(1, 1), b3 + hstepB, voffB);
            PG8_WAIT_V(6); PG8_BAR; PG8_MMA(1, 1, At, B1); PG8_BAR;
            }
        }
        if constexpr (ALIGN_EPI) { if (wr == 0) PG8_BAR; }
        if constexpr (!Epi::AFTER_DRAIN) { E(acc, cur, wr, wc, fr, fq); S.done(cur); }
        if (!has_next) break;
#pragma unroll
        for (int a = 0; a < 2; ++a)
#pragma unroll
            for (int b = 0; b < 2; ++b)
#pragma unroll
                for (int m = 0; m < 4; ++m)
#pragma unroll
                    for (int n = 0; n < 2; ++n) acc[a][b][m][n] = (f32x4){0.f, 0.f, 0.f, 0.f};
        cur = nxt; cA = nA; cB = nB; ++ui;
        if constexpr (ALIGN_EPI) { if (wr == 1) PG8_BAR; }
    }
    PG8_WAIT_V(0);
    if constexpr (!ALIGN_EPI) { if (wr == 0) PG8_BAR; }
    PG8_BAR;
    if constexpr (Epi::AFTER_DRAIN) { E.fused(acc, cur, wr, wc, fr, fq, lds, wid, lane); S.done(cur); }
#undef PG8_ABASE
#undef PG8_BBASE
#undef PG8_SA
#undef PG8_SB
#undef PG8_STAGE
#undef PG8_LDA
#undef PG8_LDB
#undef PG8_MMA
#undef PG8_WAIT_V
#undef PG8_WAIT_L
#undef PG8_BAR
#undef PG8_SCHED
}
}

namespace att {
constexpr int ZP = N1;
constexpr int STAGE = 35840, LSM_OFF = 3 * STAGE, XB_STRIDE = 129;
__device__ __forceinline__ int crow(int r, int hi) { return (r & 3) + 8 * (r >> 2) + 4 * hi; }

struct UnitArgs {
    const bf16* zq;
    const bf16* vt_lat; const bf16* vt_ctx;
    const float* qgain;
    bf16* yo;
    int qrow0;
    int tq0;
    int krow_lat;
    int krow_ctx;
    int kcol;
    int qcol0;
    int ycol0;
    int kt0, nlat;
    float M2;
    float sinkl2;
    const float* sink;
    int hq0;
    float lam, oscale;
    const float* subln;
};

template <int MODE>
__device__ __forceinline__ void attn_unit(LAS unsigned char* lds, const int tid_in, const UnitArgs& A) {
    int tid = tid_in; asm volatile("" : "+v"(tid));
    constexpr int KROWB = MODE == 0 ? 272 : 144;
    constexpr int VRS = 144;
    constexpr int KSZ = 64 * KROWB;
    constexpr int NDT = MODE == 0 ? 4 : 2;
    constexpr int NLD = MODE == 0 ? 2 : 1;
    constexpr int KCH = MODE == 0 ? 16 : 8;
    const int lane = tid & 63, r32 = lane & 31, hh = lane >> 5;
    const int w = __builtin_amdgcn_readfirstlane(tid >> 6);
    const int wrow = MODE == 0 ? 32 * (w & 3) : 32 * (w & 1);
    const int half = MODE == 0 ? (w >> 2) : 0;
    const int qcol = MODE == 0 ? A.qcol0 + half * 64 : A.qcol0 + (w >> 1) * 64;
    const int khalf = MODE == 0 ? half * 128 : 0;
    const bool lat = A.tq0 >= 0;

    bf16x8 qf[4];
    {
        const bf16* qp = A.zq + (size_t)(A.qrow0 + wrow + r32) * ZP + qcol + 8 * hh;
        float y[4][8]; float ss = 0.f;
#pragma unroll
        for (int ks = 0; ks < 4; ++ks) { const v4u raw = *(const v4u*)(qp + 16 * ks);
            y[ks][0] = bf_lo(raw.x); y[ks][1] = bf_hi(raw.x); y[ks][2] = bf_lo(raw.y); y[ks][3] = bf_hi(raw.y);
            y[ks][4] = bf_lo(raw.z); y[ks][5] = bf_hi(raw.z); y[ks][6] = bf_lo(raw.w); y[ks][7] = bf_hi(raw.w);
#pragma unroll
            for (int j = 0; j < 8; ++j) ss += y[ks][j] * y[ks][j]; }
        ss = xsum32(ss);
        const float rstd = rsqrtf(ss * (1.0f / 64.0f) + EPS);
#pragma unroll
        for (int ks = 0; ks < 4; ++ks)
#pragma unroll
            for (int j = 0; j < 8; ++j) y[ks][j] *= rstd * A.qgain[16 * ks + 8 * hh + j];
        if (lat) {
            const int t = A.tq0 + wrow + r32; const float prow = (float)(t >> 6), pcol = (float)(t & 63);
#pragma unroll
            for (int j = 0; j < 8; ++j) { const float inv = exp2f(-(float)(8 * hh + j) * (13.287712379549449f / 16.0f));
                const float ar = prow * inv, ac = pcol * inv; const float cr = __cosf(ar), sr = __sinf(ar), cc = __cosf(ac), sc = __sinf(ac);
                const float a1 = y[0][j], a2 = y[2][j]; y[0][j] = a1 * cr - a2 * sr; y[2][j] = a2 * cr + a1 * sr;
                const float b1 = y[1][j], b2 = y[3][j]; y[1][j] = b1 * cc - b2 * sc; y[3][j] = b2 * cc + b1 * sc; }
        }
#pragma unroll
        for (int ks = 0; ks < 4; ++ks) { v4u pk; pk.x = cvt_pk_bf16(y[ks][0] * QSCALE, y[ks][1] * QSCALE); pk.y = cvt_pk_bf16(y[ks][2] * QSCALE, y[ks][3] * QSCALE);
            pk.z = cvt_pk_bf16(y[ks][4] * QSCALE, y[ks][5] * QSCALE); pk.w = cvt_pk_bf16(y[ks][6] * QSCALE, y[ks][7] * QSCALE); qf[ks] = __builtin_bit_cast(bf16x8, pk); }
    }
    const int tq = lat ? A.tq0 + wrow + r32 : 0;

    f32x16 o[NDT];
#pragma unroll
    for (int dt = 0; dt < NDT; ++dt)
#pragma unroll
        for (int r = 0; r < 16; ++r) o[dt][r] = 0.f;
    const f32x16 zero16 = {0.f, 0.f, 0.f, 0.f, 0.f, 0.f, 0.f, 0.f, 0.f, 0.f, 0.f, 0.f, 0.f, 0.f, 0.f, 0.f};
    float lsum = 0.f;

    const int nt = (lat ? A.nlat : 0) + 4;
    v4u kreg[NLD], vreg[NLD];
#define ATT_SRC(ii) const int i_ = (ii); const bool loc = lat && i_ < A.nlat; const int j_ = loc ? (A.kt0 + i_) : (i_ - (lat ? A.nlat : 0));
#define ATT_LOAD_K(ii) do { ATT_SRC(ii) \
        const bf16* kb = A.zq + (size_t)((loc ? A.krow_lat : A.krow_ctx) + 64 * j_) * ZP + A.kcol; \
        _Pragma("unroll") for (int n = 0; n < NLD; ++n) { const int c = tid + 512 * n; kreg[n] = *(const v4u*)(kb + (size_t)(c / KCH) * ZP + (c % KCH) * 8); } } while (0)
#define ATT_LOAD_V(ii) do { ATT_SRC(ii) \
        const bf16* vb = (loc ? A.vt_lat : A.vt_ctx) + 64 * j_; const int vpt = loc ? T : CT; \
        _Pragma("unroll") for (int n = 0; n < NLD; ++n) { const int c = tid + 512 * n; vreg[n] = *(const v4u*)(vb + (size_t)(c >> 3) * vpt + (c & 7) * 8); } } while (0)
#define ATT_WRITE_K(st) do { LAS unsigned char* Kw = lds + (st) * STAGE; \
        _Pragma("unroll") for (int n = 0; n < NLD; ++n) { const int c = tid + 512 * n; *(LAS v4u*)(Kw + (c / KCH) * KROWB + (c % KCH) * 16) = kreg[n]; } } while (0)
#define ATT_WRITE_V(st) do { LAS unsigned char* Vw = lds + (st) * STAGE + KSZ; \
        _Pragma("unroll") for (int n = 0; n < NLD; ++n) { const int c = tid + 512 * n; { LAS v2u* vw_ = (LAS v2u*)(Vw + (c >> 3) * VRS + ((c & 7) >> 1) * 32 + (c & 1) * 8); v2u a_; a_.x = vreg[n].x; a_.y = vreg[n].y; v2u b_; b_.x = vreg[n].z; b_.y = vreg[n].w; vw_[0] = a_; vw_[2] = b_; }     } } while (0)
#define ATT_LOAD_TILE(ii) do { ATT_LOAD_K(ii); ATT_LOAD_V(ii); } while (0)
#define ATT_WRITE_TILE(st) do { ATT_WRITE_K(st); ATT_WRITE_V(st); } while (0)

#define ATT_EXP8(P, base, koff) do { _Pragma("unroll") for (int r = (base); r < (base) + 8; ++r) { float e_ = __builtin_amdgcn_exp2f(P[r]); \
        if (MODE == 1) { if (msk) { const int dlt = kv0m + (koff) + (r & 3) + 8 * (r >> 2); if (dlt > 128 || dlt < -128) e_ = 0.f; } } \
        P[r] = e_; lsum += e_; } } while (0)
#define ATT_VFRAG(dst, dt_, s__) do { dst = *(const LAS bf16x8*)(vp + (dt_) * 32 * VRS + 32 * (s__)); } while (0)
#define ATT_STEP(C0, C1, N0, N1, ii, PRE) do { const int i_s = (ii); const bool more = (PRE) || (i_s + 2 < nt); const bool more3 = (PRE) || (i_s + 3 < nt); \
        const LAS unsigned char* kpn = lds + st_nxt * STAGE + r32 * KROWB + khalf + 16 * hh; \
        const LAS unsigned char* vp = lds + st_cur * STAGE + KSZ + r32 * VRS + 16 * hh; \
        const bool msk = (MODE == 1) && lat && (i_s < A.nlat); const int kv0m = 64 * (A.kt0 + i_s) + 4 * hh - tq; \
        { const bf16x8 a0 = *(const LAS bf16x8*)(kpn); const bf16x8 a1 = *(const LAS bf16x8*)(kpn + 32 * KROWB); \
          N0 = __builtin_amdgcn_mfma_f32_32x32x16_bf16(a0, qf[0], zero16, 0, 0, 0); N1 = __builtin_amdgcn_mfma_f32_32x32x16_bf16(a1, qf[0], zero16, 0, 0, 0); } \
        ATT_EXP8(C0, 0, 0); \
        { const bf16x8 a0 = *(const LAS bf16x8*)(kpn + 32); const bf16x8 a1 = *(const LAS bf16x8*)(kpn + 32 * KROWB + 32); \
          N0 = __builtin_amdgcn_mfma_f32_32x32x16_bf16(a0, qf[1], N0, 0, 0, 0); N1 = __builtin_amdgcn_mfma_f32_32x32x16_bf16(a1, qf[1], N1, 0, 0, 0); } \
        ATT_EXP8(C0, 8, 0); \
        { const bf16x8 a0 = *(const LAS bf16x8*)(kpn + 64); const bf16x8 a1 = *(const LAS bf16x8*)(kpn + 32 * KROWB + 64); \
          N0 = __builtin_amdgcn_mfma_f32_32x32x16_bf16(a0, qf[2], N0, 0, 0, 0); N1 = __builtin_amdgcn_mfma_f32_32x32x16_bf16(a1, qf[2], N1, 0, 0, 0); } \
        ATT_EXP8(C1, 0, 32); \
        { const bf16x8 a0 = *(const LAS bf16x8*)(kpn + 96); const bf16x8 a1 = *(const LAS bf16x8*)(kpn + 32 * KROWB + 96); \
          N0 = __builtin_amdgcn_mfma_f32_32x32x16_bf16(a0, qf[3], N0, 0, 0, 0); N1 = __builtin_amdgcn_mfma_f32_32x32x16_bf16(a1, qf[3], N1, 0, 0, 0); } \
        ATT_EXP8(C1, 8, 32); \
        if (more) { ATT_WRITE_K(st_wr); } if (more3) { ATT_LOAD_K(i_s + 3); } \
        bf16x8 vf[2][NDT]; \
        _Pragma("unroll") for (int dt = 0; dt < NDT; ++dt) { ATT_VFRAG(vf[0][dt], dt, 0); } \
        bf16x8 pa[4]; \
        { v4u t0, t1, t2, t3; \
          t0.x = cvt_pk_bf16(C0[0], C0[1]); t0.y = cvt_pk_bf16(C0[2], C0[3]); t0.z = cvt_pk_bf16(C0[4], C0[5]); t0.w = cvt_pk_bf16(C0[6], C0[7]); \
          t1.x = cvt_pk_bf16(C0[8], C0[9]); t1.y = cvt_pk_bf16(C0[10], C0[11]); t1.z = cvt_pk_bf16(C0[12], C0[13]); t1.w = cvt_pk_bf16(C0[14], C0[15]); \
          t2.x = cvt_pk_bf16(C1[0], C1[1]); t2.y = cvt_pk_bf16(C1[2], C1[3]); t2.z = cvt_pk_bf16(C1[4], C1[5]); t2.w = cvt_pk_bf16(C1[6], C1[7]); \
          t3.x = cvt_pk_bf16(C1[8], C1[9]); t3.y = cvt_pk_bf16(C1[10], C1[11]); t3.z = cvt_pk_bf16(C1[12], C1[13]); t3.w = cvt_pk_bf16(C1[14], C1[15]); \
          pa[0] = __builtin_bit_cast(bf16x8, t0); pa[1] = __builtin_bit_cast(bf16x8, t1); pa[2] = __builtin_bit_cast(bf16x8, t2); pa[3] = __builtin_bit_cast(bf16x8, t3); } \
        _Pragma("unroll") for (int s_ = 0; s_ < 4; ++s_) { \
            if (s_ < 3) { _Pragma("unroll") for (int dt = 0; dt < NDT; ++dt) { ATT_VFRAG(vf[(s_ + 1) & 1][dt], dt, s_ + 1); } } \
            _Pragma("unroll") for (int dt = 0; dt < NDT; ++dt) o[dt] = __builtin_amdgcn_mfma_f32_32x32x16_bf16(pa[s_], vf[s_ & 1][dt], o[dt], 0, 0, 0); } \
        if (more) { ATT_WRITE_V(st_wr); } if (more3) { ATT_LOAD_V(i_s + 3); } \
        __syncthreads(); \
        { const int t_ = st_cur; st_cur = st_nxt; st_nxt = st_wr; st_wr = t_; } } while (0)

    int st_cur = 0, st_nxt = 1, st_wr = 2;
    ATT_LOAD_TILE(0); ATT_WRITE_TILE(0); ATT_LOAD_TILE(1); ATT_WRITE_TILE(1); __syncthreads();
    ATT_LOAD_TILE(2);
    f32x16 cA0, cA1, cB0, cB1;
    {
        const LAS unsigned char* kp = lds + r32 * KROWB + khalf + 16 * hh;
#pragma unroll
        for (int ks = 0; ks < 4; ++ks) {
            const bf16x8 a0 = *(const LAS bf16x8*)(kp + 32 * ks);
            const bf16x8 a1 = *(const LAS bf16x8*)(kp + 32 * KROWB + 32 * ks);
            if (ks == 0) { cA0 = __builtin_amdgcn_mfma_f32_32x32x16_bf16(a0, qf[0], zero16, 0, 0, 0); cA1 = __builtin_amdgcn_mfma_f32_32x32x16_bf16(a1, qf[0], zero16, 0, 0, 0); }
            else { cA0 = __builtin_amdgcn_mfma_f32_32x32x16_bf16(a0, qf[ks], cA0, 0, 0, 0); cA1 = __builtin_amdgcn_mfma_f32_32x32x16_bf16(a1, qf[ks], cA1, 0, 0, 0); }
        }
    }
    int i = 0;
    for (; i + 4 < nt; i += 2) {
        ATT_STEP(cA0, cA1, cB0, cB1, i, true);
        ATT_STEP(cB0, cB1, cA0, cA1, i + 1, true);
    }
    for (; i < nt; i += 2) {
        ATT_STEP(cA0, cA1, cB0, cB1, i, false);
        if (i + 1 < nt) ATT_STEP(cB0, cB1, cA0, cA1, i + 1, false);
    }
#undef ATT_STEP
#undef ATT_VFRAG
#undef ATT_EXP8

    LAS float* lsm = (LAS float*)(lds + LSM_OFF);
    {
    int t3 = tid_in; asm volatile("" : "+v"(t3)); const int r32 = t3 & 31, hh = (t3 >> 5) & 1;
    float lt = xsum32(lsum);
    if (MODE == 1) lt += __builtin_amdgcn_exp2f(A.sink[A.hq0 + (w >> 1)] * LOG2E);
    if (hh == 0) lsm[w * 32 + r32] = lt;
    __syncthreads();
    if (MODE == 1) {
        LAS bf16* ost = (LAS bf16*)lds;
#pragma unroll
        for (int r = 0; r < 16; ++r) { const int q = crow(r, hh); const float f = __builtin_amdgcn_rcpf(lsm[w * 32 + q]);
#pragma unroll
            for (int dt = 0; dt < NDT; ++dt) ost[(wrow + q) * 264 + (w >> 1) * 64 + 32 * dt + r32] = (bf16)(cvt_pk_bf16(o[dt][r] * f, 0.f) & 0xffffu); }
        __syncthreads();
        { const int te = w * 64 + (t3 & 63);
#pragma unroll
          for (int n = 0; n < 4; ++n) { const int c = te + 512 * n, row = c >> 5, ch = c & 31;
              *(v4u*)(A.yo + (size_t)(A.qrow0 + row) * YW + A.ycol0 + ch * 8) = *(const LAS v4u*)((LAS unsigned char*)lds + row * 528 + ch * 16); } }
        __syncthreads();
    } else {
        LAS float* Xb = (LAS float*)lds;
        if (w >= 4) {
#pragma unroll
            for (int r = 0; r < 16; ++r) { const int q = crow(r, hh); const float f = -A.lam * __builtin_amdgcn_rcpf(lsm[w * 32 + q]);
#pragma unroll
                for (int dt = 0; dt < NDT; ++dt) Xb[(wrow + q) * XB_STRIDE + 32 * dt + r32] = o[dt][r] * f; }
        }
        __syncthreads();
        if (w < 4) {
            LAS bf16* ost = (LAS bf16*)(lds + 66560);
            float sl[NDT];
#pragma unroll
            for (int dt = 0; dt < NDT; ++dt) sl[dt] = A.subln[32 * dt + r32] * A.oscale;
#pragma unroll
            for (int r = 0; r < 16; ++r) { const int q = crow(r, hh); const float f = __builtin_amdgcn_rcpf(lsm[w * 32 + q]);
                float v[NDT]; float ss = 0.f;
#pragma unroll
                for (int dt = 0; dt < NDT; ++dt) { v[dt] = o[dt][r] * f + Xb[(wrow + q) * XB_STRIDE + 32 * dt + r32]; ss += v[dt] * v[dt]; }
                ss += swz_xor<1>(ss); ss += swz_xor<2>(ss); ss += swz_xor<4>(ss); ss += swz_xor<8>(ss); ss += swz_xor<16>(ss);
                const float rstd = rsqrtf(ss * (1.0f / 128.0f) + EPS);
#pragma unroll
                for (int dt = 0; dt < NDT; ++dt) ost[(wrow + q) * 136 + 32 * dt + r32] = (bf16)(cvt_pk_bf16(v[dt] * rstd * sl[dt], 0.f) & 0xffffu); }
        }
        __syncthreads();
        { const int te = w * 64 + (t3 & 63);
#pragma unroll
          for (int n = 0; n < 4; ++n) { const int c = te + 512 * n, row = c >> 4, ch = c & 15;
              *(v4u*)(A.yo + (size_t)(A.qrow0 + row) * YW + A.ycol0 + ch * 8) = *(const LAS v4u*)(lds + 66560 + row * 272 + ch * 16); } }
        __syncthreads();
    }
    }
}
#undef ATT_LOAD_TILE
#undef ATT_WRITE_TILE
#undef ATT_LOAD_K
#undef ATT_LOAD_V
#undef ATT_WRITE_K
#undef ATT_WRITE_V
#undef ATT_SRC
}


namespace mg {
constexpr int BK = 32, RS = 80, TILE_B = 256 * RS, STG = 2 * TILE_B;

template <int ACT  > struct EpiStore {
    bf16* O; int ldc;
    __device__ __forceinline__ void operator()(const f32x16 (&acc)[4][2], const pg8::Unit& u, int wm, int wn, int r32, int hh) const {
#pragma unroll
        for (int mi = 0; mi < 4; ++mi) { bf16* rowp = O + (size_t)(u.pm * 256 + wm * 128 + mi * 32 + r32) * ldc + u.pn * 256 + wn * 64 + 4 * hh;
#pragma unroll
            for (int ni = 0; ni < 2; ++ni)
#pragma unroll
                for (int g = 0; g < 4; ++g) { float v[4];
#pragma unroll
                    for (int e = 0; e < 4; ++e) { float x = acc[mi][ni][4 * g + e];
                        if (ACT == 1) x = pg8::act_sigmoid(x);
                        if (ACT == 2) { x = fmaxf(x, 0.f); x = x * x; }
                        v[e] = x; }
                    v2u w; w.x = cvt_pk_bf16(v[0], v[1]); w.y = cvt_pk_bf16(v[2], v[3]);
                    *(v2u*)(rowp + ni * 32 + 8 * g) = w; } }
    }
};
struct EpiGate {
    bf16* G; int ldc;
    __device__ __forceinline__ void operator()(const f32x16 (&acc)[4][2], const pg8::Unit& u, int wm, int wn, int r32, int hh) const {
#pragma unroll
        for (int mi = 0; mi < 4; ++mi) { bf16* rowp = G + (size_t)(u.pm * 256 + wm * 128 + mi * 32 + r32) * ldc + u.pn * 256 + wn * 64 + 4 * hh;
#pragma unroll
            for (int ni = 0; ni < 2; ++ni)
#pragma unroll
                for (int g = 0; g < 4; ++g) { const v2u q = *(const v2u*)(rowp + ni * 32 + 8 * g);
                    v2u w; w.x = cvt_pk_bf16(acc[mi][ni][4 * g] * bf_lo(q.x), acc[mi][ni][4 * g + 1] * bf_hi(q.x)); w.y = cvt_pk_bf16(acc[mi][ni][4 * g + 2] * bf_lo(q.y), acc[mi][ni][4 * g + 3] * bf_hi(q.y));
                    *(v2u*)(rowp + ni * 32 + 8 * g) = w; } }
    }
};
struct EpiResid {
    const float* res_lat; const float* res_ctx; float* out_lat; float* out_ctx; const float* modg;
    __device__ __forceinline__ void operator()(const f32x16 (&acc)[4][2], const pg8::Unit& u, int wm, int wn, int r32, int hh) const {
        const int r0 = u.pm * 256; const bool lat = r0 < MLAT;
        const float* res = lat ? res_lat : res_ctx - (size_t)MLAT * D; float* out = lat ? out_lat : out_ctx - (size_t)MLAT * D;
        const float* mg_ = modg + (size_t)(lat ? (r0 / T) : NB) * 6144 + u.pn * 256 + wn * 64 + 4 * hh;
#pragma unroll
        for (int ni = 0; ni < 2; ++ni)
#pragma unroll
            for (int g = 0; g < 4; ++g) { const f32x4 gv = *(const f32x4*)(mg_ + ni * 32 + 8 * g);
#pragma unroll
                for (int mi = 0; mi < 4; ++mi) { const size_t ro = (size_t)(r0 + wm * 128 + mi * 32 + r32) * D + u.pn * 256 + wn * 64 + 4 * hh + ni * 32 + 8 * g;
                    const f32x4 r = *(const f32x4*)(res + ro);
                    f32x4 a; a.x = acc[mi][ni][4 * g]; a.y = acc[mi][ni][4 * g + 1]; a.z = acc[mi][ni][4 * g + 2]; a.w = acc[mi][ni][4 * g + 3];
                    *(f32x4*)(out + ro) = r + gv * a; } }
    }
};

template <class Epi>
__device__ __forceinline__ void gemm(LAS unsigned char* lds, const int tid, const pg8::Gemm g, const pg8::StaticOrder& S, const Epi& E) {
    const int lane = tid & 63, r32 = lane & 31, hh = lane >> 5;
    const int w = __builtin_amdgcn_readfirstlane(tid >> 6), wm = w >> 2, wn = w & 3;
    const int nk = g.K / BK;
    const int lrow = tid >> 2, lkc = tid & 3;
    pg8::Unit u;
    for (int ui = 0; S.next(ui, u); ++ui) {
        const bf16* Ab = g.A + (size_t)u.pm * 256 * g.lda + (g.agrp ? (size_t)(u.pn / g.agrp) * g.agstride : (size_t)0) + (size_t)lrow * g.lda + lkc * 8;
        const bf16* Bb = g.Bt + (size_t)u.pn * 256 * g.ldb + (size_t)lrow * g.ldb + lkc * 8;
        f32x16 acc[4][2];
#pragma unroll
        for (int mi = 0; mi < 4; ++mi)
#pragma unroll
            for (int ni = 0; ni < 2; ++ni)
#pragma unroll
                for (int r = 0; r < 16; ++r) acc[mi][ni][r] = 0.f;
        v4u ar[2], br[2];
#define MG_LOAD(kt_) do { const int ko = (kt_) * BK; \
        ar[0] = *(const v4u*)(Ab + ko); ar[1] = *(const v4u*)(Ab + (size_t)128 * g.lda + ko); \
        br[0] = *(const v4u*)(Bb + ko); br[1] = *(const v4u*)(Bb + (size_t)128 * g.ldb + ko); } while (0)
#define MG_WRITE(st_) do { LAS unsigned char* Aw = lds + (st_) * STG + lrow * RS + lkc * 16; \
        *(LAS v4u*)(Aw) = ar[0]; *(LAS v4u*)(Aw + 128 * RS) = ar[1]; \
        *(LAS v4u*)(Aw + TILE_B) = br[0]; *(LAS v4u*)(Aw + TILE_B + 128 * RS) = br[1]; } while (0)
        MG_LOAD(0); MG_WRITE(0); __syncthreads();
        for (int kt = 0; kt < nk; ++kt) {
            if (kt + 1 < nk) MG_LOAD(kt + 1);
            const LAS unsigned char* As = lds + (kt & 1) * STG + (wm * 128 + r32) * RS + 16 * hh;
            const LAS unsigned char* Bs = lds + (kt & 1) * STG + TILE_B + (wn * 64 + r32) * RS + 16 * hh;
#pragma unroll
            for (int ks = 0; ks < 2; ++ks) {
                bf16x8 af[4], bq[2];
#pragma unroll
                for (int mi = 0; mi < 4; ++mi) af[mi] = *(const LAS bf16x8*)(As + mi * 32 * RS + 32 * ks);
#pragma unroll
                for (int ni = 0; ni < 2; ++ni) bq[ni] = *(const LAS bf16x8*)(Bs + ni * 32 * RS + 32 * ks);
#pragma unroll
                for (int mi = 0; mi < 4; ++mi)
#pragma unroll
                    for (int ni = 0; ni < 2; ++ni) acc[mi][ni] = __builtin_amdgcn_mfma_f32_32x32x16_bf16(bq[ni], af[mi], acc[mi][ni], 0, 0, 0);
            }
            if (kt + 1 < nk) MG_WRITE((kt + 1) & 1);
            __syncthreads();
        }
#undef MG_LOAD
#undef MG_WRITE
        E(acc, u, wm, wn, r32, hh);
    }
}
}


#define XB_TMO      128
#define XB_XCNT(j)  (256  + 64 * (j))
#define XB_XSUB(j)  (1280 + 64 * (j))
#define XB_XGEN(j)  (2304 + 64 * (j))
#define XB_TOP      3328
#define XB_TOPGEN   3392
#define XCD_BAR_WORDS 3456
#define XB_SPIN_CAP (1u << 18)

__device__ __forceinline__ unsigned xb_ld(unsigned* p)              { return __hip_atomic_load(p, __ATOMIC_RELAXED, __HIP_MEMORY_SCOPE_AGENT); }
__device__ __forceinline__ unsigned xb_add(unsigned* p, unsigned v) { return __hip_atomic_fetch_add(p, v, __ATOMIC_RELAXED, __HIP_MEMORY_SCOPE_AGENT); }
__device__ __forceinline__ unsigned xb_xcc_id() { return (unsigned)__builtin_amdgcn_s_getreg((3 << 11) | 20) & 0xFu; }
#define XB_SPIN(cond, bar) do { unsigned _sp = 0; while (cond) { __builtin_amdgcn_s_sleep(1); \
    if ((++_sp & 255u) == 0u) { if (xb_ld(&(bar)[XB_TMO])) break; if (_sp > XB_SPIN_CAP) { atomicAdd(&(bar)[XB_TMO], 1u); break; } } } } while (0)

struct XcdBarrier {
    unsigned* bar; unsigned x;
    volatile LAS unsigned* st;
};

__device__ __forceinline__ XcdBarrier xcd_barrier_post(unsigned* bar, volatile LAS unsigned* st) {
    XcdBarrier b; b.bar = bar; b.x = xb_xcc_id(); b.st = st;
    if (threadIdx.x == 0) (void)xb_add(&bar[XB_XCNT(b.x)], 1u);
    return b;
}
__device__ __forceinline__ void xcd_barrier_complete(unsigned* bar, unsigned x, unsigned& nloc, unsigned& nx) {
    const unsigned G = gridDim.x * gridDim.y * gridDim.z;
    unsigned sum, cnt, mine, sp = 0u;
    for (;;) {
        sum = 0u; cnt = 0u; mine = 0u;
#pragma unroll
        for (unsigned j = 0; j < 16; ++j) { const unsigned c = xb_ld(&bar[XB_XCNT(j)]); sum += c; cnt += (c > 0u) ? 1u : 0u; mine = (j == x) ? c : mine; }
        if (sum == G) break;
        __builtin_amdgcn_s_sleep(1);
        if ((++sp & 255u) == 0u) { if (xb_ld(&bar[XB_TMO])) break; if (sp > XB_SPIN_CAP) { atomicAdd(&bar[XB_TMO], 1u); break; } }
    }
    nloc = mine > 0u ? mine : 1u; nx = cnt > 0u ? cnt : 1u;
}

__device__ __forceinline__ void xcd_barrier(const XcdBarrier& b, const bool is_t0) {
    asm volatile("s_waitcnt vmcnt(0)" ::: "memory");
    __syncthreads();
    if (is_t0) {
        unsigned* bar = b.bar;
        __builtin_amdgcn_s_waitcnt(0);
        unsigned nloc = b.st[0], nx = b.st[1];
        if (nloc == 0u) { xcd_barrier_complete(bar, b.x, nloc, nx); b.st[0] = nloc; b.st[1] = nx; }
        const unsigned old = xb_add(&bar[XB_XSUB(b.x)], 1u);
        const unsigned gen = old / nloc;
        if (old + 1u == (gen + 1u) * nloc) {
            __builtin_amdgcn_fence(__ATOMIC_RELEASE, "agent");
            asm volatile("s_waitcnt vmcnt(0)" ::: "memory");
            const unsigned og = xb_add(&bar[XB_TOP], 1u);
            const unsigned tg = og / nx;
            if (og + 1u == (tg + 1u) * nx) xb_add(&bar[XB_TOPGEN], 1u);
            else XB_SPIN(xb_ld(&bar[XB_TOPGEN]) == tg, bar);
            __builtin_amdgcn_fence(__ATOMIC_ACQUIRE, "agent");
            xb_add(&bar[XB_XGEN(b.x)], 1u);
            asm volatile("s_waitcnt vmcnt(0)" ::: "memory");
        } else {
            XB_SPIN(xb_ld(&bar[XB_XGEN(b.x)]) == gen, bar);
            __builtin_amdgcn_fence(__ATOMIC_ACQUIRE, "agent");
            asm volatile("s_waitcnt vmcnt(0)" ::: "memory");
        }
    }
    __syncthreads();
}

struct Args {
    const float* in[24]; float* out; unsigned char* ws;
    int ph_lo, ph_hi;
};
struct Frame {
    LAS unsigned char* lds; int tid, lane, wave, G, vcu, gw, NGW, bx;
};

__device__ __forceinline__ void tr_item(const float* W, int ldw, int Nsub, bf16* WT, int ldt, LAS float* scr, int item, int lane) {
    const int nblk = Nsub / 32, kb = item / nblk, nb = item % nblk, k0 = 64 * kb, n0 = 32 * nb;
#pragma unroll 8
    for (int i = 0; i < 32; ++i) { const int kk = 2 * i + (lane >> 5); scr[kk * 33 + (lane & 31)] = W[(size_t)(k0 + kk) * ldw + n0 + (lane & 31)]; }
    asm volatile("s_waitcnt lgkmcnt(0)" ::: "memory");
    const int c = lane & 7;
#pragma unroll
    for (int j = 0; j < 4; ++j) { const int n = (lane >> 3) + 8 * j; const LAS float* s = scr + (8 * c) * 33 + n;
        v4u o; o.x = cvt_pk_bf16(s[0 * 33], s[1 * 33]); o.y = cvt_pk_bf16(s[2 * 33], s[3 * 33]); o.z = cvt_pk_bf16(s[4 * 33], s[5 * 33]); o.w = cvt_pk_bf16(s[6 * 33], s[7 * 33]);
        *(v4u*)(WT + (size_t)(n0 + n) * ldt + k0 + 8 * c) = o; }
    asm volatile("s_waitcnt lgkmcnt(0)" ::: "memory");
}

__device__ __forceinline__ void norm_mod_rows(const Frame& F, const float* xlat, const float* xctx, const float* gain, const float* modl, int ch_shift, int ch_scale, bf16* XN) {
#pragma unroll 2
    for (int r = F.gw; r < MTOT; r += F.NGW) {
        const bool lat = r < MLAT; const float* xrow = lat ? xlat + (size_t)r * D : xctx + (size_t)(r - MLAT) * D;
        const float* mb = modl + (size_t)(lat ? r / T : NB) * 6144;
        const f32x4* xr = (const f32x4*)xrow + F.lane;
        f32x4 v[4]; float s = 0.f;
#pragma unroll
        for (int j = 0; j < 4; ++j) { v[j] = xr[64 * j]; s += (v[j].x * v[j].x + v[j].y * v[j].y) + (v[j].z * v[j].z + v[j].w * v[j].w); }
        const float rstd = rsqrtf(wave_sum(s) * (1.f / D) + EPS);
        v2u* o8 = (v2u*)(XN + (size_t)r * D) + F.lane;
#pragma unroll
        for (int j = 0; j < 4; ++j) { const int c = 4 * F.lane + 256 * j;
            const f32x4 g = *(const f32x4*)(gain + c), sh = *(const f32x4*)(mb + ch_shift * 1024 + c), sc = *(const f32x4*)(mb + ch_scale * 1024 + c);
            const f32x4 y = v[j] * rstd * g * (sc + 1.0f) + sh;
            v2u pk; pk.x = cvt_pk_bf16(y.x, y.y); pk.y = cvt_pk_bf16(y.z, y.w); o8[64 * j] = pk; }
    }
}


template <int KIND>
__device__ __forceinline__ void simple_gemm(const Frame& F, const bf16* A, int lda, int agrp_cols, int agstride, const bf16* Bt, int ldb, int M, int N, int K,
                                            bf16* O, int ldc, const float* res_lat_, const float* res_ctx_, float* out_lat_, float* out_ctx_, const float* modg) {
    const int r32 = F.lane & 31, hh = F.lane >> 5; const int ntn = N / 32, ntiles = (M / 32) * ntn;
    for (int tt = F.gw; tt < ntiles; tt += F.NGW) {
        const int tm = tt / ntn, tn = tt % ntn;
        const int aoff = agrp_cols ? ((tn * 32) / agrp_cols) * agstride : 0;
        const bf16* ap = A + (size_t)(tm * 32 + r32) * lda + aoff + 8 * hh;
        const bf16* bp = Bt + (size_t)(tn * 32 + r32) * ldb + 8 * hh;
        f32x16 acc;
#pragma unroll
        for (int r = 0; r < 16; ++r) acc[r] = 0.f;
        for (int k0 = 0; k0 < K; k0 += 16) {
            const bf16x8 a = *(const bf16x8*)(ap + k0), b = *(const bf16x8*)(bp + k0);
            acc = __builtin_amdgcn_mfma_f32_32x32x16_bf16(a, b, acc, 0, 0, 0);
        }
        const int col = tn * 32 + r32;
#pragma unroll
        for (int r = 0; r < 16; ++r) { const int row = tm * 32 + (r & 3) + 8 * (r >> 2) + 4 * hh; float v = acc[r];
            if (KIND == 1) v = pg8::act_sigmoid(v);
            if (KIND == 2) { v = fmaxf(v, 0.f); v = v * v; }
            if (KIND <= 2) O[(size_t)row * ldc + col] = (bf16)(cvt_pk_bf16(v, 0.f) & 0xffffu);
            if (KIND == 3) { bf16* gp = O + (size_t)row * ldc + col; *gp = (bf16)(cvt_pk_bf16(v * bf1(*gp), 0.f) & 0xffffu); }
            if (KIND == 4) { const bool lat = row < MLAT; const int bidx = lat ? row / T : NB;
                const float* rp = lat ? res_lat_ + (size_t)row * D : res_ctx_ + (size_t)(row - MLAT) * D; float* op = lat ? out_lat_ + (size_t)row * D : out_ctx_ + (size_t)(row - MLAT) * D;
                op[col] = rp[col] + modg[(size_t)bidx * 6144 + col] * v; } }
    }
}

__global__ void __launch_bounds__(NWAVES * 64, 2) fwd_mega(Args args) {
    extern __shared__ __attribute__((aligned(16))) unsigned char lds_raw[];
    cg::grid_group grid = cg::this_grid();
    Frame F;
    F.lds = (LAS unsigned char*)lds_raw;
    F.tid = threadIdx.x; F.lane = F.tid & 63; F.wave = __builtin_amdgcn_readfirstlane(F.tid >> 6);
    const int wave_s = __builtin_amdgcn_readfirstlane((int)threadIdx.x >> 6);
    F.G = gridDim.x; { const int bx = blockIdx.x; F.vcu = (F.G % 8 == 0) ? (bx % 8) * (F.G / 8) + bx / 8 : bx; }
    F.gw = blockIdx.x * NWAVES + F.wave; F.NGW = F.G * NWAVES;
    volatile LAS unsigned* xb_st = (volatile LAS unsigned*)(F.lds + 132096);
    if (threadIdx.x == 0) { xb_st[0] = 0u; xb_st[1] = 0u; }
    __syncthreads();
    XcdBarrier bar = xcd_barrier_post((unsigned*)(args.ws + WS_CTL) + 4096, xb_st);
    if (args.ph_hi < 0) grid.sync();
#define AS4 __attribute__((address_space(4)))
#define INP(i) (*(const float* const AS4*)(kp + 8 * (i)))
#define ws (*(unsigned char* const AS4*)(kp + 200))
#define out (*(float* const AS4*)(kp + 192))
#define x_in INP(0)
#define c_in INP(1)
#define ctx_in INP(2)
#define cctx_in INP(3)
#define w_ada INP(4)
#define b_ada INP(5)
#define norm1 INP(6)
#define norm2 INP(7)
#define w_in INP(8)
#define w_pool INP(9)
#define pool_scale INP(10)
#define swa_qn INP(11)
#define swa_kn INP(12)
#define swa_sink INP(13)
#define diff_qn INP(14)
#define diff_kn INP(15)
#define diff_lambda INP(16)
#define diff_subln INP(17)
#define w_br_pool INP(18)
#define w_br_swa INP(19)
#define w_br_diff INP(20)
#define w_out INP(21)
#define w_ff1 INP(22)
#define w_ff2 INP(23)
#define mod ((float*)(ws + WS_MOD))
#define lamv ((float*)(ws + WS_LAM))
#define XC ((float*)(ws + WS_XC))
#define XN ((bf16*)(ws + WS_XN))
#define Y ((bf16*)(ws + WS_Y))
#define Z1 ((bf16*)(ws + WS_BIG + BO_Z1))
#define VT ((bf16*)(ws + WS_BIG + BO_VT))
#define GB ((bf16*)(ws + WS_BIG + BO_G))
#define MG ((bf16*)(ws + WS_BIG + BO_MG))
#define HB ((bf16*)(ws + WS_BIG + BO_H))
#define wl (ws + WS_W + (size_t)l * WL_STRIDE)
#define modl (mod + (size_t)l * 5 * 6144)
#define res_lat (l == 0 ? x_in : (const float*)out)
#define res_ctx (l == 0 ? ctx_in : (const float*)XC)
    int ph = 0;
    const int lo = args.ph_lo, hi = args.ph_hi;
#define PH_BEGIN if (lo <= ph && ph < hi) { const AS4 char* kp = (const AS4 char*)__builtin_amdgcn_kernarg_segment_ptr(); asm volatile("" : "+s"(kp)); \
    { int tid_ = wave_s * 64 + (int)__builtin_amdgcn_mbcnt_hi(~0u, __builtin_amdgcn_mbcnt_lo(~0u, 0u)); asm volatile("" : "+v"(tid_)); F.tid = tid_; F.lane = tid_ & 63; F.wave = __builtin_amdgcn_readfirstlane(tid_ >> 6); int bx_ = blockIdx.x; asm volatile("" : "+s"(bx_)); int G_ = gridDim.x; asm volatile("" : "+s"(G_)); F.bx = bx_; F.G = G_; F.vcu = (G_ % 8 == 0) ? (bx_ % 8) * (G_ / 8) + bx_ / 8 : bx_; F.gw = bx_ * NWAVES + F.wave; F.NGW = G_ * NWAVES; }
#define PH_END(dosync) if ((dosync) && ph + 1 < hi) { xcd_barrier(bar, F.tid == 0); } } ++ph;

    PH_BEGIN
    {
        LAS float* sc = (LAS float*)F.lds;
        LAS float* part = sc + 5 * 1024;
        if (F.bx < 192) {
            for (int i = F.tid; i < 5 * 1024; i += 512) { const int v = i >> 10, k = i & 1023; const float cv = v < NB ? c_in[v * D + k] : cctx_in[k]; sc[i] = cv / (1.0f + __expf(-cv)); }
            __syncthreads();
            for (int it = F.bx; it < 192; it += F.G) {
                const int l = it / 96, n = (it % 96) * 64 + F.lane;
                const float* wp = w_ada + (size_t)l * D * 6144 + (size_t)(F.wave * 128) * 6144 + n;
                float a0 = 0.f, a1 = 0.f, a2 = 0.f, a3 = 0.f, a4 = 0.f;
#pragma unroll 8
                for (int k = 0; k < 128; ++k) { const float wv = wp[(size_t)k * 6144]; const int kk = F.wave * 128 + k;
                    a0 += sc[kk] * wv; a1 += sc[1024 + kk] * wv; a2 += sc[2048 + kk] * wv; a3 += sc[3072 + kk] * wv; a4 += sc[4096 + kk] * wv; }
                part[(F.wave * 5 + 0) * 64 + F.lane] = a0; part[(F.wave * 5 + 1) * 64 + F.lane] = a1; part[(F.wave * 5 + 2) * 64 + F.lane] = a2;
                part[(F.wave * 5 + 3) * 64 + F.lane] = a3; part[(F.wave * 5 + 4) * 64 + F.lane] = a4;
                __syncthreads();
                if (F.tid < 320) { const int v = F.tid >> 6, ln = F.tid & 63; float s = 0.f;
#pragma unroll
                    for (int wv = 0; wv < 8; ++wv) s += part[(wv * 5 + v) * 64 + ln];
                    const int nn = (it % 96) * 64 + ln; mod[((size_t)l * 5 + v) * 6144 + nn] = s + b_ada[(size_t)l * 6144 + nn]; }
                __syncthreads();
            }
        }
        __syncthreads();
        if (F.gw == F.NGW - 1) {
            for (int l = 0; l < NL; ++l) { const float* dl = diff_lambda + (size_t)l * 256;
                const float s1 = wave_sum(dl[F.lane] * dl[64 + F.lane]), s2 = wave_sum(dl[128 + F.lane] * dl[192 + F.lane]);
                const float lam_init = 0.8f - 0.6f * expf(-0.3f * (float)l);
                if (F.lane == 0) lamv[l] = expf(s1) - expf(s2) + lam_init;
                float gq = fabsf(diff_qn[l * 64 + F.lane]), gk = fabsf(diff_kn[l * 64 + F.lane]), sq = fabsf(swa_qn[l * 64 + F.lane]), sk = fabsf(swa_kn[l * 64 + F.lane]);
                gq = wave_max(gq); gk = wave_max(gk); sq = wave_max(sq); sk = wave_max(sk);
                if (F.lane == 0) { lamv[8 + 2 * l] = 64.0f * QSCALE * gq * gk * 1.01f + 0.25f; lamv[8 + 2 * l + 1] = 64.0f * QSCALE * sq * sk * 1.01f + 0.25f; } }
        }
        LAS float* scr = (LAS float*)(F.lds + 32768 + F.wave * 8704);
        constexpr int I_IN1 = 16 * (N1 / 32), I_G = 16 * (NG / 32), I_BR = 8 * 32, I_OUT = 16 * 32, I_1 = 16 * (FF / 32), I_2 = 64 * 32;
        constexpr int I_LAYER = I_IN1 + I_G + 2 * I_BR + I_OUT + I_1 + I_2;
        for (int it = F.gw; it < NL * I_LAYER; it += F.NGW) {
            const int l = it / I_LAYER; int r = it % I_LAYER;
            if (r < I_IN1) { tr_item(w_in + (size_t)l * D * DIN, DIN, N1, (bf16*)(wl + WO_IN1), D, scr, r, F.lane); continue; } r -= I_IN1;
            if (r < I_G) { tr_item(w_in + (size_t)l * D * DIN + N1, DIN, NG, (bf16*)(wl + WO_G), D, scr, r, F.lane); continue; } r -= I_G;
            if (r < I_BR) { tr_item(w_br_swa + (size_t)l * 512 * D, D, D, (bf16*)(wl + WO_BR) + (size_t)1024 * 512, 512, scr, r, F.lane); continue; } r -= I_BR;
            if (r < I_BR) { tr_item(w_br_diff + (size_t)l * 512 * D, D, D, (bf16*)(wl + WO_BR) + (size_t)2048 * 512, 512, scr, r, F.lane); continue; } r -= I_BR;
            if (r < I_OUT) { tr_item(w_out + (size_t)l * D * D, D, D, (bf16*)(wl + WO_OUT), D, scr, r, F.lane); continue; } r -= I_OUT;
            if (r < I_1) { tr_item(w_ff1 + (size_t)l * D * FF, FF, FF, (bf16*)(wl + WO_1), D, scr, r, F.lane); continue; } r -= I_1;
            tr_item(w_ff2 + (size_t)l * FF * D, D, D, (bf16*)(wl + WO_2), FF, scr, r, F.lane);
        }
        for (int it = F.gw; it < NL * 512; it += F.NGW) {
            const int l = it / 512, k = it % 512, g = k >> 7, i = k & 127;
            const float* wp = w_pool + ((size_t)(l * 4 + g) * 128 + i) * 128; const float* ps = pool_scale + (size_t)l * 512 + g * 128;
            const float* wb = w_br_pool + (size_t)l * 512 * D + (size_t)(g * 128) * D + F.lane;
            float acc[16];
#pragma unroll
            for (int p = 0; p < 16; ++p) acc[p] = 0.f;
            for (int j = 0; j < 128; ++j) { const float a = wp[j] * ps[j];
#pragma unroll
                for (int p = 0; p < 16; ++p) acc[p] += a * wb[(size_t)j * D + p * 64]; }
            bf16* wt = (bf16*)(ws + WS_W + (size_t)l * WL_STRIDE + WO_BR);
#pragma unroll
            for (int p = 0; p < 16; ++p) wt[(size_t)(p * 64 + F.lane) * 512 + k] = (bf16)(cvt_pk_bf16(acc[p], 0.f) & 0xffffu);
        }
    }
    PH_END(true)

    PH_BEGIN
    norm_mod_rows(F, x_in, ctx_in, norm1, mod, 0, 1, XN);
    PH_END(true)

    for (int l = 0; l < NL; ++l) {
        const int MEFF = (l + 1 < NL) ? MTOT : MLAT;

        PH_BEGIN
#ifdef SG_P1
        simple_gemm<0>(F, XN, D, 0, 0, (const bf16*)(wl + WO_IN1), D, MTOT, N1, D, Z1, N1, nullptr, nullptr, nullptr, nullptr, nullptr);
#else
        { pg8::Gemm g{XN, (const bf16*)(wl + WO_IN1), MTOT, N1, D, D, D, 0, 0}; pg8::StaticOrder S; S.init(MTOT, N1, F.G, F.bx);
          pg8::EpiStore<0> E{Z1, N1};
          pg8::gemm_phase<pg8::EpiStore<0>, pg8::StaticOrder, true, true>(F.lds, F.tid, g, S, E); }
#endif
        PH_END(true)

        PH_BEGIN
        {
            const float* kn_s = swa_kn + l * 64; const float* kn_d = diff_kn + l * 64;
            {
                const int sub = F.lane >> 3, c = F.lane & 7;
                float inv8[8];
#pragma unroll
                for (int j = 0; j < 8; ++j) inv8[j] = exp2f(-(float)(8 * (c & 1) + j) * (13.287712379549449f / 16.0f));
                for (int q0 = 8 * F.gw; q0 < MTOT * 10; q0 += 8 * F.NGW) {
                    const int q = q0 + sub, r = q / 10, hd = q - r * 10;
                    const bool lat = r < MLAT;
                    const int col = (hd < 2 ? C_KS + hd * 64 : C_KD + (hd - 2) * 64) + 8 * c;
                    const float* gp = (hd < 2 ? kn_s : kn_d) + 8 * c;
                    bf16* zp = Z1 + (size_t)r * N1 + col;
                    const v4u raw = *(const v4u*)zp;
                    float y[8];
                    y[0] = bf_lo(raw.x); y[1] = bf_hi(raw.x); y[2] = bf_lo(raw.y); y[3] = bf_hi(raw.y); y[4] = bf_lo(raw.z); y[5] = bf_hi(raw.z); y[6] = bf_lo(raw.w); y[7] = bf_hi(raw.w);
                    float ss = 0.f;
#pragma unroll
                    for (int j = 0; j < 8; ++j) ss += y[j] * y[j];
                    ss += swz_xor<1>(ss); ss += swz_xor<2>(ss); ss += swz_xor<4>(ss);
                    const float rstd = rsqrtf(ss * (1.f / 64.f) + EPS);
                    const f32x4 g0 = *(const f32x4*)gp, g1 = *(const f32x4*)(gp + 4);
                    y[0] *= rstd * g0.x; y[1] *= rstd * g0.y; y[2] *= rstd * g0.z; y[3] *= rstd * g0.w; y[4] *= rstd * g1.x; y[5] *= rstd * g1.y; y[6] *= rstd * g1.z; y[7] *= rstd * g1.w;
                    if (lat) {
                        const int t = r & (T - 1); const float pos = ((c & 3) < 2) ? (float)(t >> 6) : (float)(t & 63);
#pragma unroll
                        for (int j = 0; j < 8; ++j) { const float yp = swz_xor<4>(y[j]); const float ang = pos * inv8[j]; const float cs = __cosf(ang), sn = __sinf(ang);
                            y[j] = (c < 4) ? (y[j] * cs - yp * sn) : (y[j] * cs + yp * sn); }
                    }
                    v4u o; o.x = cvt_pk_bf16(y[0], y[1]); o.y = cvt_pk_bf16(y[2], y[3]); o.z = cvt_pk_bf16(y[4], y[5]); o.w = cvt_pk_bf16(y[6], y[7]);
                    *(v4u*)zp = o;
                }
            }
            LAS bf16* S = (LAS bf16*)(F.lds + F.wave * 8448);
            for (int it = F.gw; it < 528 * 10; it += F.NGW) {
                const int rb = it / 10, cgp = it % 10; const bool lat = rb < 512;
                const int b = lat ? rb >> 7 : (rb - 512) >> 2, t0 = lat ? (rb & 127) * 64 : ((rb - 512) & 3) * 64;
                const int row0 = lat ? b * T + t0 : MLAT + b * CT + t0; const int pitch = lat ? T : CT;
                int col0; bf16* dst;
                if (cgp < 2) { col0 = C_VS + cgp * 64; dst = VT + (lat ? VT_VS_LAT : VT_VS_CTX) / 2 + (size_t)((b * 2 + cgp) * 64) * pitch + t0; }
                else { const int h = (cgp - 2) >> 1, dh = (cgp - 2) & 1; col0 = C_VD + h * 128 + dh * 64; dst = VT + (lat ? VT_VD_LAT : VT_VD_CTX) / 2 + (size_t)((b * 4 + h) * 128 + dh * 64) * pitch + t0; }
#pragma unroll
                for (int i = 0; i < 8; ++i) { const int tl = i * 8 + (F.lane >> 3), ch = F.lane & 7;
                    const v4u v = *(const v4u*)(Z1 + (size_t)(row0 + tl) * N1 + col0 + ch * 8);
                    LAS unsigned* sp = (LAS unsigned*)(S + tl * 66 + ch * 8); sp[0] = v.x; sp[1] = v.y; sp[2] = v.z; sp[3] = v.w; }
                asm volatile("s_waitcnt lgkmcnt(0)" ::: "memory");
#pragma unroll
                for (int i = 0; i < 8; ++i) { const int d = i * 8 + (F.lane >> 3), tc = F.lane & 7; const LAS bf16* sp = S + (tc * 8) * 66 + d;
                    v4u o; o.x = (unsigned)sp[0] | ((unsigned)sp[66] << 16); o.y = (unsigned)sp[2 * 66] | ((unsigned)sp[3 * 66] << 16);
                    o.z = (unsigned)sp[4 * 66] | ((unsigned)sp[5 * 66] << 16); o.w = (unsigned)sp[6 * 66] | ((unsigned)sp[7 * 66] << 16);
                    *(v4u*)(dst + (size_t)d * pitch + tc * 8) = o; }
                asm volatile("s_waitcnt lgkmcnt(0)" ::: "memory");
            }
            for (int rb = F.gw; rb < 2112; rb += F.NGW) {
                const bool lat = rb < 2048;
                const int b = lat ? rb >> 9 : (rb - 2048) >> 4, t0 = lat ? (rb & 511) * 16 : ((rb - 2048) & 15) * 16;
                const int s0 = lat ? b * T : MLAT + b * CT, n = lat ? T : CT;
                const int hw = 1 << (F.lane >> 4);
                const bf16* ub = Z1 + (size_t)s0 * N1 + C_U + F.lane * 8;
                float Sm[8];
#pragma unroll
                for (int e = 0; e < 8; ++e) Sm[e] = 0.f;
#define POOL_ACC(ti, sgn) do { const v4u q_ = *(const v4u*)(ub + (size_t)(ti) * N1); \
                    Sm[0] += (sgn) * bf_lo(q_.x); Sm[1] += (sgn) * bf_hi(q_.x); Sm[2] += (sgn) * bf_lo(q_.y); Sm[3] += (sgn) * bf_hi(q_.y); \
                    Sm[4] += (sgn) * bf_lo(q_.z); Sm[5] += (sgn) * bf_hi(q_.z); Sm[6] += (sgn) * bf_lo(q_.w); Sm[7] += (sgn) * bf_hi(q_.w); } while (0)
                { const int i0 = max(t0 - hw, 0), i1 = min(t0 + hw - 1, n - 1);
                  for (int i = i0; i <= i1; ++i) POOL_ACC(i, 1.0f); }
#pragma unroll 4
                for (int t = t0; t < t0 + 16; ++t) {
                    const float rc = 1.0f / (float)(min(t + hw, n) - max(t - hw, 0));
                    const v4u q = *(const v4u*)(ub + (size_t)t * N1);
                    v4u o; o.x = cvt_pk_bf16(Sm[0] * rc - bf_lo(q.x), Sm[1] * rc - bf_hi(q.x)); o.y = cvt_pk_bf16(Sm[2] * rc - bf_lo(q.y), Sm[3] * rc - bf_hi(q.y));
                    o.z = cvt_pk_bf16(Sm[4] * rc - bf_lo(q.z), Sm[5] * rc - bf_hi(q.z)); o.w = cvt_pk_bf16(Sm[6] * rc - bf_lo(q.w), Sm[7] * rc - bf_hi(q.w));
                    *(v4u*)(Y + (size_t)(s0 + t) * YW + F.lane * 8) = o;
                    if (t + hw <= n - 1) POOL_ACC(t + hw, 1.0f);
                    if (t - hw >= 0) POOL_ACC(t - hw, -1.0f);
                }
#undef POOL_ACC
            }
        }
        PH_END(true)

        PH_BEGIN
        {
            const float M2d = lamv[8 + 2 * l], M2s = lamv[8 + 2 * l + 1];
            const float lam = lamv[l], lam_init = 0.8f - 0.6f * expf(-0.3f * (float)l);
            att::UnitArgs A;
            A.zq = Z1; A.yo = Y; A.sinkl2 = 0.f; A.sink = swa_sink + l * 8; A.lam = lam; A.oscale = 1.0f - lam_init; A.subln = diff_subln + l * 128;
            const int nu = (l + 1 < NL) ? 1024 + 32 : 1024;
            for (int u = F.vcu, cdone = 0; ; u += F.G) {
                const bool lq = u < 1024; int v = u - 1024;
                if (!lq) { if (nu == 1024) break;
                    if (F.G == 256) { if (cdone || (F.vcu & 7) != 0) break; v = F.vcu >> 3; cdone = 1; } else if (v >= 32) break; }
                const int b = lq ? (u >> 8) : (v >> 3), h = lq ? ((u >> 6) & 3) : ((v >> 1) & 3), qb = lq ? (u & 63) : (v & 1);
                A.vt_lat = VT + VT_VD_LAT / 2 + (size_t)((b * 4 + h) * 128) * T; A.vt_ctx = VT + VT_VD_CTX / 2 + (size_t)((b * 4 + h) * 128) * CT;
                A.qgain = diff_qn + l * 64; A.qrow0 = lq ? b * T + qb * 128 : MLAT + b * CT + qb * 128; A.tq0 = lq ? qb * 128 : -1; A.krow_lat = b * T; A.krow_ctx = MLAT + b * CT;
                A.kcol = C_KD + h * 128; A.qcol0 = C_QD + h * 128; A.ycol0 = 1024 + h * 128; A.kt0 = 0; A.nlat = lq ? T / 64 : 0; A.M2 = M2d; A.hq0 = 0;
                att::attn_unit<0>(F.lds, F.tid, A);
            }
            for (int u = F.vcu, cdone = 0; ; u += F.G) {
                const bool lq = u < 1024; int v = u - 1024;
                if (!lq) { if (nu == 1024) break;
                    if (F.G == 256) { if (cdone || (F.vcu & 7) != 4) break; v = F.vcu >> 3; cdone = 1; } else if (v >= 32) break; }
                const int b = lq ? (u >> 8) : (v >> 3), kvh = lq ? ((u >> 7) & 1) : ((v >> 2) & 1), qb = lq ? (u & 127) : (v & 3);
                A.vt_lat = VT + VT_VS_LAT / 2 + (size_t)((b * 2 + kvh) * 64) * T; A.vt_ctx = VT + VT_VS_CTX / 2 + (size_t)((b * 2 + kvh) * 64) * CT;
                A.qgain = swa_qn + l * 64; A.qrow0 = lq ? b * T + qb * 64 : MLAT + b * CT + qb * 64; A.tq0 = lq ? qb * 64 : -1; A.krow_lat = b * T; A.krow_ctx = MLAT + b * CT;
                A.kcol = C_KS + kvh * 64; A.qcol0 = C_QS + kvh * 256; A.ycol0 = 512 + kvh * 256;
                const int k0 = max(qb - 2, 0), k1 = min(qb + 2, T / 64 - 1); A.kt0 = lq ? k0 : 0; A.nlat = lq ? k1 - k0 + 1 : 0; A.M2 = M2s; A.hq0 = kvh * 4;
                att::attn_unit<1>(F.lds, F.tid, A);
            }
        }
        PH_END(true)

        PH_BEGIN
#ifdef SG_P3A
        simple_gemm<1>(F, XN, D, 0, 0, (const bf16*)(wl + WO_G), D, MTOT, NG, D, GB, NG, nullptr, nullptr, nullptr, nullptr, nullptr);
#else
        { pg8::Gemm g{XN, (const bf16*)(wl + WO_G), MEFF, NG, D, D, D, 0, 0}; pg8::StaticOrder S; S.init(MEFF, NG, F.G, F.bx);
          pg8::EpiStore<1> E{GB, NG};
          pg8::gemm_phase<pg8::EpiStore<1>, pg8::StaticOrder, true, true>(F.lds, F.tid, g, S, E); }
#endif
        PH_END(true)

        PH_BEGIN
#ifdef SG_P3
        simple_gemm<3>(F, Y, YW, 1024, 512, (const bf16*)(wl + WO_BR), 512, MTOT, NG, 512, GB, NG, nullptr, nullptr, nullptr, nullptr, nullptr);
#else
        { pg8::Gemm g{Y, (const bf16*)(wl + WO_BR), MEFF, NG, 512, YW, 512, 4, 512}; pg8::StaticOrder S; S.init(MEFF, NG, F.G, F.bx);
          pg8::EpiGate E{GB, NG};
          pg8::gemm_phase<pg8::EpiGate, pg8::StaticOrder, true, true>(F.lds, F.tid, g, S, E); }
#endif
        PH_END(true)

        PH_BEGIN
#pragma unroll 4
        for (size_t i = (size_t)F.bx * 512 + F.tid; i < (size_t)MEFF * 128; i += (size_t)F.G * 512) {
            const size_t r = i >> 7; const int c = (int)(i & 127) * 8; const bf16* gp = GB + r * NG + c;
            const v4u a = *(const v4u*)gp, b = *(const v4u*)(gp + 1024), d = *(const v4u*)(gp + 2048);
            v4u o; o.x = cvt_pk_bf16(bf_lo(a.x) + bf_lo(b.x) + bf_lo(d.x), bf_hi(a.x) + bf_hi(b.x) + bf_hi(d.x)); o.y = cvt_pk_bf16(bf_lo(a.y) + bf_lo(b.y) + bf_lo(d.y), bf_hi(a.y) + bf_hi(b.y) + bf_hi(d.y));
            o.z = cvt_pk_bf16(bf_lo(a.z) + bf_lo(b.z) + bf_lo(d.z), bf_hi(a.z) + bf_hi(b.z) + bf_hi(d.z)); o.w = cvt_pk_bf16(bf_lo(a.w) + bf_lo(b.w) + bf_lo(d.w), bf_hi(a.w) + bf_hi(b.w) + bf_hi(d.w));
            *(v4u*)(MG + r * D + c) = o;
        }
        PH_END(true)

        PH_BEGIN
#ifdef SG_P4
        simple_gemm<4>(F, MG, D, 0, 0, (const bf16*)(wl + WO_OUT), D, MTOT, D, D, nullptr, 0, res_lat, res_ctx, out, XC, modl + 2 * 1024);
#else
        { pg8::Gemm g{MG, (const bf16*)(wl + WO_OUT), MEFF, D, D, D, D, 0, 0}; pg8::StaticOrder S; S.init(MEFF, D, F.G, F.bx);
          pg8::EpiResid E{res_lat, res_ctx, out, XC, modl + 2 * 1024};
          pg8::gemm_phase<pg8::EpiResid, pg8::StaticOrder, true, true>(F.lds, F.tid, g, S, E); }
#endif
        PH_END(true)

        PH_BEGIN
        norm_mod_rows(F, out, XC, norm2 + l * D, modl, 3, 4, XN);
        PH_END(true)

        PH_BEGIN
#ifdef SG_P5
        simple_gemm<2>(F, XN, D, 0, 0, (const bf16*)(wl + WO_1), D, MTOT, FF, D, HB, FF, nullptr, nullptr, nullptr, nullptr, nullptr);
#else
        { pg8::Gemm g{XN, (const bf16*)(wl + WO_1), MEFF, FF, D, D, D, 0, 0}; pg8::StaticOrder S; S.init(MEFF, FF, F.G, F.bx);
          pg8::EpiStore<2> E{HB, FF};
          pg8::gemm_phase<pg8::EpiStore<2>, pg8::StaticOrder, true, true>(F.lds, F.tid, g, S, E); }
#endif
        PH_END(true)

        PH_BEGIN
#ifdef SG_P6
        simple_gemm<4>(F, HB, FF, 0, 0, (const bf16*)(wl + WO_2), FF, MTOT, D, FF, nullptr, 0, out, XC, out, XC, modl + 5 * 1024);
#else
        { pg8::Gemm g{HB, (const bf16*)(wl + WO_2), MEFF, D, FF, FF, FF, 0, 0}; pg8::StaticOrder S; S.init(MEFF, D, F.G, F.bx);
          pg8::EpiResid E{out, XC, out, XC, modl + 5 * 1024};
          pg8::gemm_phase<pg8::EpiResid, pg8::StaticOrder, true, true>(F.lds, F.tid, g, S, E); }
#endif
        PH_END(l + 1 < NL)

        if (l + 1 < NL) {
            PH_BEGIN
            norm_mod_rows(F, out, XC, norm1 + (l + 1) * D, mod + (size_t)(l + 1) * 5 * 6144, 0, 1, XN);
            PH_END(true)
        }
    }
#undef PH_BEGIN
#undef PH_END
}

#undef AS4
#undef INP
#undef ws
#undef out
#undef x_in
#undef c_in
#undef ctx_in
#undef cctx_in
#undef w_ada
#undef b_ada
#undef norm1
#undef norm2
#undef w_in
#undef w_pool
#undef pool_scale
#undef swa_qn
#undef swa_kn
#undef swa_sink
#undef diff_qn
#undef diff_kn
#undef diff_lambda
#undef diff_subln
#undef w_br_pool
#undef w_br_swa
#undef w_br_diff
#undef w_out
#undef w_ff1
#undef w_ff2
#undef mod
#undef lamv
#undef XC
#undef XN
#undef Y
#undef Z1
#undef VT
#undef GB
#undef MG
#undef HB
#undef wl
#undef modl
#undef res_lat
#undef res_ctx
extern "C" void kernel_launch(void* const* d_in, const int* in_sizes, int n_in, void* d_out, int out_size, void* d_ws, size_t ws_size, hipStream_t stream) {
    static int grid = 0;
    if (grid == 0) {
        if (n_in != 24 || in_sizes[0] != MLAT * D || out_size != MLAT * D || ws_size < WS_END) {
            fprintf(stderr, "kernel_launch: unexpected shapes / workspace (n_in %d, in0 %d, out %d, ws %zu, need %zu); nothing launched\n", n_in, n_in > 0 ? in_sizes[0] : -1, out_size, ws_size, (size_t)WS_END); grid = -1; return; }
        int dev = 0, cus = 0, per_cu = 0;
        if (hipGetDevice(&dev) != hipSuccess || hipDeviceGetAttribute(&cus, hipDeviceAttributeMultiprocessorCount, dev) != hipSuccess) { grid = -1; return; }
        if (hipFuncSetAttribute((const void*)fwd_mega, hipFuncAttributeMaxDynamicSharedMemorySize, LDS_BYTES) != hipSuccess) { fprintf(stderr, "kernel_launch: hipFuncSetAttribute failed\n"); grid = -1; return; }
        if (hipOccupancyMaxActiveBlocksPerMultiprocessor(&per_cu, (const void*)fwd_mega, NWAVES * 64, LDS_BYTES) != hipSuccess || per_cu < 1) { fprintf(stderr, "kernel_launch: occupancy query says %d\n", per_cu); per_cu = 1; }
        (void)hipGetLastError();
        grid = cus * 1;
    }
    if (grid < 0) return;
    if (hipMemsetAsync((char*)d_ws + WS_CTL, 0, 1 << 20, stream) != hipSuccess) { fprintf(stderr, "kernel_launch: memset failed\n"); return; }
    Args a{};
    for (int i = 0; i < 24; ++i) a.in[i] = (const float*)d_in[i];
    a.out = (float*)d_out; a.ws = (unsigned char*)d_ws; a.ph_lo = 0; a.ph_hi = 1000;
    void* kargs[] = {&a};
    hipError_t e = hipLaunchCooperativeKernel((void*)fwd_mega, dim3(grid), dim3(NWAVES * 64), kargs, LDS_BYTES, stream);
    if (e != hipSuccess) fprintf(stderr, "cooperative launch failed: %s (grid %d)\n", hipGetErrorString(e), grid);
}
```

```cpp
#include <hip/hip_runtime.h>
#include <hip/hip_cooperative_groups.h>
#include <cstdio>
#include <cstdint>
#include <type_traits>
namespace cg = cooperative_groups;

constexpr int NB = 4, T = 8192, D = 1024, NL = 2, CT = 256, FF = 4096;
constexpr int MLAT = NB * T, MCTX = NB * CT, MTOT = MLAT + MCTX;
constexpr int DIN = 5888, N1 = 2816, NG = 3072, YW = 1536;
constexpr int C_U = 0, C_QS = 512, C_KS = 1024, C_VS = 1152, C_QD = 1280, C_KD = 1792, C_VD = 2304;
constexpr float EPS = 1e-6f;
constexpr float QSCALE = 0.125f * 1.4426950408889634f;
constexpr float LOG2E = 1.4426950408889634f;

constexpr size_t MiB = 1u << 20;
constexpr size_t WS_CTL = 0;
constexpr size_t WS_MOD = 1 * MiB;
constexpr size_t WS_LAM = 1 * MiB + 512 * 1024;
constexpr size_t WS_W = 2 * MiB, WL_STRIDE = 33 * MiB;
constexpr size_t WO_IN1 = 0, WO_G = 5 * MiB + 512 * 1024, WO_BR = 11 * MiB + 512 * 1024, WO_OUT = 14 * MiB + 512 * 1024, WO_1 = 16 * MiB + 512 * 1024, WO_2 = 24 * MiB + 512 * 1024;
constexpr size_t WS_XC = 68 * MiB;
constexpr size_t WS_XN = 72 * MiB;
constexpr size_t WS_Y = 138 * MiB;
constexpr size_t WS_BIG = 237 * MiB;
constexpr size_t BO_Z1 = 0, BO_VT = 182 * MiB, BO_G = 0, BO_MG = 198 * MiB, BO_H = 0;
constexpr size_t VT_VS_LAT = 0, VT_VD_LAT = 8 * MiB, VT_VS_CTX = 40 * MiB, VT_VD_CTX = 40 * MiB + 256 * 1024;
constexpr size_t WS_END = 501 * MiB;
static_assert((size_t)MTOT * N1 * 2 <= BO_VT && BO_VT + 42 * MiB <= 264 * MiB && (size_t)MTOT * NG * 2 <= BO_MG && BO_MG + (size_t)MTOT * D * 2 <= 264 * MiB && (size_t)MTOT * FF * 2 <= 264 * MiB, "BIG map");
static_assert(WS_XN + (size_t)MTOT * D * 2 <= WS_Y && WS_Y + (size_t)MTOT * YW * 2 <= WS_BIG && WS_BIG + 264 * MiB <= WS_END, "ws map");

constexpr int LDS_BYTES = 147456;
constexpr int NWAVES = 8;

#define LAS __attribute__((address_space(3)))
typedef unsigned short bf16;
typedef unsigned v4u __attribute__((ext_vector_type(4)));
typedef unsigned v2u __attribute__((ext_vector_type(2)));
typedef float f32x4 __attribute__((ext_vector_type(4)));
typedef float f32x16 __attribute__((ext_vector_type(16)));
typedef short bf16x8 __attribute__((ext_vector_type(8)));
typedef short s16x4 __attribute__((ext_vector_type(4)));

typedef float f32x2_t __attribute__((ext_vector_type(2))); typedef __bf16 bf16x2_t __attribute__((ext_vector_type(2)));
__device__ __forceinline__ unsigned cvt_pk_bf16(float lo, float hi) { f32x2_t v = {lo, hi}; bf16x2_t b = __builtin_convertvector(v, bf16x2_t); return __builtin_bit_cast(unsigned, b); }
__device__ __forceinline__ float bf_lo(unsigned u) { return __builtin_bit_cast(float, u << 16); }
__device__ __forceinline__ float bf_hi(unsigned u) { return __builtin_bit_cast(float, u & 0xffff0000u); }
__device__ __forceinline__ float bf1(bf16 h) { return __builtin_bit_cast(float, (unsigned)h << 16); }
template <int X> __device__ __forceinline__ float swz_xor(float v) { return __builtin_bit_cast(float, __builtin_amdgcn_ds_swizzle(__builtin_bit_cast(int, v), (X << 10) | 0x1f)); }
__device__ __forceinline__ float xsum32(float v) { const unsigned u = __builtin_bit_cast(unsigned, v); auto rr = __builtin_amdgcn_permlane32_swap(u, u, false, false); return __builtin_bit_cast(float, (unsigned)rr[0]) + __builtin_bit_cast(float, (unsigned)rr[1]); }
__device__ __forceinline__ float xmax32(float v) { const unsigned u = __builtin_bit_cast(unsigned, v); auto rr = __builtin_amdgcn_permlane32_swap(u, u, false, false); return fmaxf(__builtin_bit_cast(float, (unsigned)rr[0]), __builtin_bit_cast(float, (unsigned)rr[1])); }
__device__ __forceinline__ float xget32(float v, bool lower_half) { const unsigned u = __builtin_bit_cast(unsigned, v); auto rr = __builtin_amdgcn_permlane32_swap(u, u, false, false); return lower_half ? __builtin_bit_cast(float, (unsigned)rr[1]) : __builtin_bit_cast(float, (unsigned)rr[0]); }
__device__ __forceinline__ float wave_sum(float v) { v += swz_xor<1>(v); v += swz_xor<2>(v); v += swz_xor<4>(v); v += swz_xor<8>(v); v += swz_xor<16>(v); return xsum32(v); }
__device__ __forceinline__ float wave_max(float v) { v = fmaxf(v, swz_xor<1>(v)); v = fmaxf(v, swz_xor<2>(v)); v = fmaxf(v, swz_xor<4>(v)); v = fmaxf(v, swz_xor<8>(v)); v = fmaxf(v, swz_xor<16>(v)); return xmax32(v); }

namespace pg8 {
#define PG8_LAS __attribute__((address_space(3)))
typedef unsigned short bf16_t;
typedef short bf16x8 __attribute__((ext_vector_type(8)));
typedef float f32x4 __attribute__((ext_vector_type(4)));
typedef unsigned u32x4 __attribute__((ext_vector_type(4)));
constexpr int BM = 256, BK = 64, HALF = 128, HTB = HALF * BK * 2  , STAGE_BYTES = 8 * HTB, NXCD = 8, WGM = 8;

__host__ __device__ __forceinline__ int lds_byte(int r, int c) { const int st = (r >> 4) * 2 + (c >> 5), rr = r & 15, cc = c & 31, ob = rr * 64 + cc * 2; return st * 1024 + (ob ^ (((ob >> 9) & 1) << 5)); }
__host__ __device__ __forceinline__ void stage_rc(int b, int& R, int& C) { const int st = b / 1024, sb = b % 1024, swz = sb ^ (((sb >> 9) & 1) << 5); R = (st >> 1) * 16 + swz / 64; C = (st & 1) * 32 + (swz % 64) / 2; }
__host__ __device__ __forceinline__ int perm32(int rho) { const int n = rho >> 4, i = rho & 15; return 8 * (i >> 2) + 4 * n + (i & 3); }

struct Unit { int pm, pn; };
struct Gemm { const bf16_t* A; const bf16_t* Bt; int M, N, K, lda, ldb, agrp, agstride; };

struct StaticOrder {
    int nM, nN, nwg, G, c;
    __host__ __device__ void init(int M, int N, int G_, int c_) { nM = M / BM; nN = N / BM; nwg = nM * nN; G = G_; c = c_; }
    __host__ __device__ bool next(int i, Unit& u) const {
        const long L = (long)i * G + c; if (L >= nwg) return false;
        int wgid = (int)L; { const int q = nwg / NXCD, r = nwg % NXCD, xcd = wgid % NXCD, off = wgid / NXCD; wgid = (xcd < r ? xcd * (q + 1) : r * (q + 1) + (xcd - r) * q) + off; }
        const int nig = WGM * nN, gid = wgid / nig, fm = gid * WGM, gsz = (nM - fm) < WGM ? (nM - fm) : WGM;
        u.pm = fm + ((wgid % nig) % gsz); u.pn = (wgid % nig) / gsz; return true;
    }
    __device__ __forceinline__ void a_ready(const Unit&) const {}
    __device__ __forceinline__ void done(const Unit&) const {}
};


__device__ __forceinline__ float act_sigmoid(float v) { return __builtin_amdgcn_rcpf(1.0f + __builtin_amdgcn_exp2f(-v * 1.4426950408889634f)); }
template <int ACT  > struct EpiStore {
    static constexpr bool PERM = true, AFTER_DRAIN = false;
    bf16_t* O; int ldc;
    __device__ __forceinline__ void operator()(const f32x4 (&acc)[2][2][4][2], const Unit& u, int wr, int wc, int fr, int fq) const {
        const int row0 = u.pm * BM + wr * 64 + fr, col0 = u.pn * BM + wc * 32 + 8 * fq;
#pragma unroll
        for (int ai = 0; ai < 2; ++ai)
#pragma unroll
            for (int m = 0; m < 4; ++m) { bf16_t* rowp = O + (size_t)(row0 + ai * HALF + m * 16) * ldc + col0;
#pragma unroll
                for (int bj = 0; bj < 2; ++bj) { f32x4 v0 = acc[ai][bj][m][0], v1 = acc[ai][bj][m][1];
                    if (ACT == 1) {
#pragma unroll
                        for (int e = 0; e < 4; ++e) { v0[e] = act_sigmoid(v0[e]); v1[e] = act_sigmoid(v1[e]); } }
                    if (ACT == 2) {
#pragma unroll
                        for (int e = 0; e < 4; ++e) { const float a = fmaxf(v0[e], 0.f), b = fmaxf(v1[e], 0.f); v0[e] = a * a; v1[e] = b * b; } }
                    u32x4 w; w.x = cvt_pk_bf16(v0[0], v0[1]); w.y = cvt_pk_bf16(v0[2], v0[3]); w.z = cvt_pk_bf16(v1[0], v1[1]); w.w = cvt_pk_bf16(v1[2], v1[3]);
                    *(u32x4*)(rowp + bj * HALF) = w; } }
    }
};
struct EpiGate {
    static constexpr bool PERM = true, AFTER_DRAIN = false;
    bf16_t* G; int ldc;
    __device__ __forceinline__ void operator()(const f32x4 (&acc)[2][2][4][2], const Unit& u, int wr, int wc, int fr, int fq) const {
        const int row0 = u.pm * BM + wr * 64 + fr, col0 = u.pn * BM + wc * 32 + 8 * fq;
#pragma unroll
        for (int ai = 0; ai < 2; ++ai)
#pragma unroll
            for (int m = 0; m < 4; ++m) { bf16_t* rowp = G + (size_t)(row0 + ai * HALF + m * 16) * ldc + col0;
#pragma unroll
                for (int bj = 0; bj < 2; ++bj) { const f32x4 v0 = acc[ai][bj][m][0], v1 = acc[ai][bj][m][1];
                    const u32x4 g = *(const u32x4*)(rowp + bj * HALF);
                    u32x4 w; w.x = cvt_pk_bf16(v0[0] * bf_lo(g.x), v0[1] * bf_hi(g.x)); w.y = cvt_pk_bf16(v0[2] * bf_lo(g.y), v0[3] * bf_hi(g.y));
                    w.z = cvt_pk_bf16(v1[0] * bf_lo(g.z), v1[1] * bf_hi(g.z)); w.w = cvt_pk_bf16(v1[2] * bf_lo(g.w), v1[3] * bf_hi(g.w));
                    *(u32x4*)(rowp + bj * HALF) = w; } }
    }
};
struct EpiResid {
    static constexpr bool PERM = true, AFTER_DRAIN = false;
    const float* res_lat; const float* res_ctx; float* out_lat; float* out_ctx; const float* modg;
    __device__ __forceinline__ void operator()(const f32x4 (&acc)[2][2][4][2], const Unit& u, int wr, int wc, int fr, int fq) const {
        const int r0 = u.pm * BM; const bool lat = r0 < MLAT;
        const float* res = lat ? res_lat : res_ctx - (size_t)MLAT * D; float* out = lat ? out_lat : out_ctx - (size_t)MLAT * D;
        const int bidx = lat ? (r0 / T) : NB;
        const int row0 = r0 + wr * 64 + fr, col0 = u.pn * BM + wc * 32 + 8 * fq;
        f32x4 gv[2][2];
#pragma unroll
        for (int bj = 0; bj < 2; ++bj)
#pragma unroll
            for (int n = 0; n < 2; ++n) gv[bj][n] = *(const f32x4*)(modg + (size_t)bidx * 6144 + col0 + bj * HALF + 4 * n);
#pragma unroll
        for (int ai = 0; ai < 2; ++ai)
#pragma unroll
            for (int m = 0; m < 4; ++m) { const size_t ro = (size_t)(row0 + ai * HALF + m * 16) * D + col0;
#pragma unroll
                for (int bj = 0; bj < 2; ++bj)
#pragma unroll
                    for (int n = 0; n < 2; ++n) { const f32x4 r = *(const f32x4*)(res + ro + bj * HALF + 4 * n);
                        *(f32x4*)(out + ro + bj * HALF + 4 * n) = r + gv[bj][n] * acc[ai][bj][m][n]; } }
    }
};

template <class Epi, class Sched, bool ALIGN_EPI = false, bool SP2 = false>
__device__ __forceinline__ void gemm_phase(PG8_LAS unsigned char* lds, const int tid, const Gemm g, const Sched& S, const Epi& E) {
    const int wid = __builtin_amdgcn_readfirstlane(tid >> 6), lane = tid & 63, wr = wid >> 2, wc = wid & 3, fr = lane & 15, fq = lane >> 4;
    const int K = g.K, nt = K / BK;
    unsigned voffA[2], voffB[2];
#pragma unroll
    for (int i = 0; i < 2; ++i) { int R, C; stage_rc(tid * 16 + i * 8192, R, C); const int Rb = Epi::PERM ? ((R & ~31) + perm32(R & 31)) : R;
        voffA[i] = (unsigned)(R * g.lda + C) * 2u; voffB[i] = (unsigned)(Rb * g.ldb + C) * 2u; }
    const size_t kstep = (size_t)(BK * 2);
    const size_t hstepA = (size_t)HALF * g.lda * 2, hstepB = (size_t)HALF * g.ldb * 2;
    const size_t tstepA = 2 * hstepA, tstepB = 2 * hstepB;
#define PG8_ABASE(u) ((const char*)g.A + (size_t)(u).pm * tstepA + (g.agrp ? (size_t)((u).pn / g.agrp) * (size_t)g.agstride * 2 : (size_t)0))
#define PG8_BBASE(u) ((const char*)g.Bt + (size_t)(u).pn * tstepB)
    const unsigned ldsw = (unsigned)wid * 1024u;
    const int aoff = lds_byte(wr * 64 + fr, fq * 8), boff = lds_byte(wc * 32 + fr, fq * 8);
#define PG8_SA(b, h) (((b) * 2 + (h)) * HTB)
#define PG8_SB(b, h) ((4 + (b) * 2 + (h)) * HTB)
#define PG8_STAGE(bufoff, gbase, voff) do { _Pragma("unroll") for (int _i = 0; _i < 2; ++_i) \
        __builtin_amdgcn_global_load_lds((const unsigned*)((const char*)(gbase) + (voff)[_i]), (PG8_LAS unsigned*)(lds + (bufoff) + ldsw + _i * 8192), 16, 0, 0); } while (0)
#define PG8_LDA(dst, b, h) do { _Pragma("unroll") for (int m = 0; m < 4; ++m) _Pragma("unroll") for (int k = 0; k < 2; ++k) dst[m][k] = *(const PG8_LAS bf16x8*)(lds + PG8_SA(b, h) + aoff + m * 2048 + k * 1024); } while (0)
#define PG8_LDB(dst, b, h) do { _Pragma("unroll") for (int n = 0; n < 2; ++n) _Pragma("unroll") for (int k = 0; k < 2; ++k) dst[n][k] = *(const PG8_LAS bf16x8*)(lds + PG8_SB(b, h) + boff + n * 2048 + k * 1024); } while (0)
#define PG8_MMA(ai, bj, At, Bt) do { __builtin_amdgcn_s_setprio(1); _Pragma("unroll") for (int m = 0; m < 4; ++m) _Pragma("unroll") for (int n = 0; n < 2; ++n) _Pragma("unroll") for (int k = 0; k < 2; ++k) \
        acc[ai][bj][m][n] = __builtin_amdgcn_mfma_f32_16x16x32_bf16(Bt[n][k], At[m][k], acc[ai][bj][m][n], 0, 0, 0); __builtin_amdgcn_s_setprio(0); } while (0)
#define PG8_WAIT_V(n) asm volatile("s_waitcnt vmcnt(" #n ")" ::: "memory")
#define PG8_WAIT_L(n) asm volatile("s_waitcnt lgkmcnt(" #n ")" ::: "memory")
#define PG8_BAR __builtin_amdgcn_s_barrier()
#define PG8_SCHED __builtin_amdgcn_sched_barrier(0)
    Unit cur, nxt; int ui = 0;
    if (!S.next(0, cur)) return;
    f32x4 acc[2][2][4][2];
#pragma unroll
    for (int a = 0; a < 2; ++a)
#pragma unroll
        for (int b = 0; b < 2; ++b)
#pragma unroll
            for (int m = 0; m < 4; ++m)
#pragma unroll
                for (int n = 0; n < 2; ++n) acc[a][b][m][n] = (f32x4){0.f, 0.f, 0.f, 0.f};
    bf16x8 At[4][2], B0[2][2], B1[2][2];
    const char* cA = PG8_ABASE(cur); const char* cB = PG8_BBASE(cur);
    S.a_ready(cur);
    if constexpr (SP2) {
        PG8_STAGE(PG8_SB(0, 0), cB, voffB); PG8_STAGE(PG8_SB(0, 1), cB + hstepB, voffB); PG8_STAGE(PG8_SA(0, 0), cA, voffA); PG8_STAGE(PG8_SA(0, 1), cA + hstepA, voffA);
        if (wr == 1) PG8_BAR;
        PG8_WAIT_V(2); PG8_BAR;
        PG8_STAGE(PG8_SB(1, 0), cB + kstep, voffB); PG8_STAGE(PG8_SA(1, 0), cA + kstep, voffA); PG8_STAGE(PG8_SB(1, 1), cB + hstepB + kstep, voffB);
        PG8_WAIT_V(6); PG8_BAR;
    } else {
        PG8_STAGE(PG8_SB(0, 0), cB, voffB); PG8_STAGE(PG8_SA(0, 0), cA, voffA); PG8_STAGE(PG8_SB(0, 1), cB + hstepB, voffB); PG8_STAGE(PG8_SA(0, 1), cA + hstepA, voffA);
        if (wr == 1) PG8_BAR;
        PG8_WAIT_V(4); PG8_BAR;
        PG8_STAGE(PG8_SB(1, 0), cB + kstep, voffB); PG8_STAGE(PG8_SA(1, 0), cA + kstep, voffA); PG8_STAGE(PG8_SB(1, 1), cB + hstepB + kstep, voffB);
        PG8_WAIT_V(6); PG8_BAR;
    }
    for (;;) {
        const bool has_next = S.next(ui + 1, nxt);
        const char* nA = has_next ? PG8_ABASE(nxt) : cA; const char* nB = has_next ? PG8_BBASE(nxt) : cB;
        for (int t = 0; t < nt; t += 2) {
            const bool last = (t == nt - 2);
            const char* a1 = cA + (size_t)(t + 1) * kstep;
            const char* a2 = last ? nA : cA + (size_t)(t + 2) * kstep; const char* b2 = last ? nB : cB + (size_t)(t + 2) * kstep;
            const char* a3 = a2 + kstep; const char* b3 = b2 + kstep;
            if (last && has_next) S.a_ready(nxt);
            if constexpr (SP2) {
            PG8_LDB(B0, 0, 0); PG8_LDB(B1, 0, 1); PG8_SCHED; PG8_LDA(At, 0, 0); PG8_STAGE(PG8_SA(1, 1), a1 + hstepA, voffA);
            PG8_WAIT_V(8); PG8_WAIT_L(0); PG8_BAR; PG8_MMA(0, 0, At, B0); PG8_MMA(0, 1, At, B1); PG8_BAR; PG8_SCHED;
            PG8_LDA(At, 0, 1); PG8_STAGE(PG8_SB(0, 0), b2, voffB); PG8_STAGE(PG8_SB(0, 1), b2 + hstepB, voffB); PG8_STAGE(PG8_SA(0, 0), a2, voffA);
            PG8_WAIT_V(8); PG8_WAIT_L(0); PG8_BAR; PG8_MMA(1, 0, At, B0); PG8_MMA(1, 1, At, B1); PG8_BAR; PG8_SCHED;
            PG8_LDB(B0, 1, 0); PG8_LDB(B1, 1, 1); PG8_SCHED; PG8_LDA(At, 1, 0); PG8_STAGE(PG8_SA(0, 1), a2 + hstepA, voffA);
            PG8_WAIT_V(8); PG8_WAIT_L(0); PG8_BAR; PG8_MMA(0, 0, At, B0); PG8_MMA(0, 1, At, B1); PG8_BAR; PG8_SCHED;
            PG8_LDA(At, 1, 1); PG8_STAGE(PG8_SB(1, 0), b3, voffB); PG8_STAGE(PG8_SB(1, 1), b3 + hstepB, voffB); PG8_STAGE(PG8_SA(1, 0), a3, voffA);
            PG8_WAIT_V(8); PG8_WAIT_L(0); PG8_BAR; PG8_MMA(1, 0, At, B0); PG8_MMA(1, 1, At, B1); PG8_BAR; PG8_SCHED;
            } else {
            PG8_LDB(B0, 0, 0); PG8_SCHED; PG8_LDA(At, 0, 0); PG8_STAGE(PG8_SA(1, 1), a1 + hstepA, voffA);
            PG8_WAIT_L(8); PG8_BAR; PG8_WAIT_L(0); PG8_MMA(0, 0, At, B0); PG8_BAR; PG8_SCHED;
            PG8_LDB(B1, 0, 1); PG8_STAGE(PG8_SB(0, 0), b2, voffB);
            PG8_BAR; PG8_WAIT_L(0); PG8_MMA(0, 1, At, B1); PG8_BAR;
            PG8_LDA(At, 0, 1); PG8_STAGE(PG8_SA(0, 0), a2, voffA);
            PG8_BAR; PG8_WAIT_L(0); PG8_MMA(1, 0, At, B0); PG8_BAR; PG8_SCHED;
            PG8_STAGE(PG8_SB(0, 1), b2 + hstepB, voffB);
            PG8_WAIT_V(6); PG8_BAR; PG8_MMA(1, 1, At, B1); PG8_BAR;
            PG8_LDB(B0, 1, 0); PG8_SCHED; PG8_LDA(At, 1, 0); PG8_STAGE(PG8_SA(0, 1), a2 + hstepA, voffA);
            PG8_WAIT_L(8); PG8_BAR; PG8_WAIT_L(0); PG8_MMA(0, 0, At, B0); PG8_BAR; PG8_SCHED;
            PG8_LDB(B1, 1, 1); PG8_STAGE(PG8_SB(1, 0), b3, voffB);
            PG8_BAR; PG8_WAIT_L(0); PG8_MMA(0, 1, At, B1); PG8_BAR;
            PG8_LDA(At, 1, 1); PG8_STAGE(PG8_SA(1, 0), a3, voffA);
            PG8_BAR; PG8_WAIT_L(0); PG8_MMA(1, 0, At, B0); PG8_BAR; PG8_SCHED;
            PG8_STAGE(PG8_SB(1, 1), b3 + hstepB, voffB);
            PG8_WAIT_V(6); PG8_BAR; PG8_MMA(1, 1, At, B1); PG8_BAR;
            }
        }
        if constexpr (ALIGN_EPI) { if (wr == 0) PG8_BAR; }
        if constexpr (!Epi::AFTER_DRAIN) { E(acc, cur, wr, wc, fr, fq); S.done(cur); }
        if (!has_next) break;
#pragma unroll
        for (int a = 0; a < 2; ++a)
#pragma unroll
            for (int b = 0; b < 2; ++b)
#pragma unroll
                for (int m = 0; m < 4; ++m)
#pragma unroll
                    for (int n = 0; n < 2; ++n) acc[a][b][m][n] = (f32x4){0.f, 0.f, 0.f, 0.f};
        cur = nxt; cA = nA; cB = nB; ++ui;
        if constexpr (ALIGN_EPI) { if (wr == 1) PG8_BAR; }
    }
    PG8_WAIT_V(0);
    if constexpr (!ALIGN_EPI) { if (wr == 0) PG8_BAR; }
    PG8_BAR;
    if constexpr (Epi::AFTER_DRAIN) { E.fused(acc, cur, wr, wc, fr, fq, lds, wid, lane); S.done(cur); }
#undef PG8_ABASE
#undef PG8_BBASE
#undef PG8_SA
#undef PG8_SB
#undef PG8_STAGE
#undef PG8_LDA
#undef PG8_LDB
#undef PG8_MMA
#undef PG8_WAIT_V
#undef PG8_WAIT_L
#undef PG8_BAR
#undef PG8_SCHED
}
}

namespace att {
constexpr int ZP = N1;
constexpr int STAGE = 35840, LSM_OFF = 3 * STAGE, XB_STRIDE = 129;
__device__ __forceinline__ int crow(int r, int hi) { return (r & 3) + 8 * (r >> 2) + 4 * hi; }

struct UnitArgs {
    const bf16* zq;
    const bf16* vt_lat; const bf16* vt_ctx;
    const float* qgain;
    bf16* yo;
    int qrow0;
    int tq0;
    int krow_lat;
    int krow_ctx;
    int kcol;
    int qcol0;
    int ycol0;
    int kt0, nlat;
    float M2;
    float sinkl2;
    const float* sink;
    int hq0;
    float lam, oscale;
    const float* subln;
};

template <int MODE>
__device__ __forceinline__ void attn_unit(LAS unsigned char* lds, const int tid_in, const UnitArgs& A) {
    int tid = tid_in; asm volatile("" : "+v"(tid));
    constexpr int KROWB = MODE == 0 ? 272 : 144;
    constexpr int VRS = 144;
    constexpr int KSZ = 64 * KROWB;
    constexpr int NDT = MODE == 0 ? 4 : 2;
    constexpr int NLD = MODE == 0 ? 2 : 1;
    constexpr int KCH = MODE == 0 ? 16 : 8;
    const int lane = tid & 63, r32 = lane & 31, hh = lane >> 5;
    const int w = __builtin_amdgcn_readfirstlane(tid >> 6);
    const int wrow = MODE == 0 ? 32 * (w & 3) : 32 * (w & 1);
    const int half = MODE == 0 ? (w >> 2) : 0;
    const int qcol = MODE == 0 ? A.qcol0 + half * 64 : A.qcol0 + (w >> 1) * 64;
    const int khalf = MODE == 0 ? half * 128 : 0;
    const bool lat = A.tq0 >= 0;

    bf16x8 qf[4];
    {
        const bf16* qp = A.zq + (size_t)(A.qrow0 + wrow + r32) * ZP + qcol + 8 * hh;
        float y[4][8]; float ss = 0.f;
#pragma unroll
        for (int ks = 0; ks < 4; ++ks) { const v4u raw = *(const v4u*)(qp + 16 * ks);
            y[ks][0] = bf_lo(raw.x); y[ks][1] = bf_hi(raw.x); y[ks][2] = bf_lo(raw.y); y[ks][3] = bf_hi(raw.y);
            y[ks][4] = bf_lo(raw.z); y[ks][5] = bf_hi(raw.z); y[ks][6] = bf_lo(raw.w); y[ks][7] = bf_hi(raw.w);
#pragma unroll
            for (int j = 0; j < 8; ++j) ss += y[ks][j] * y[ks][j]; }
        ss = xsum32(ss);
        const float rstd = rsqrtf(ss * (1.0f / 64.0f) + EPS);
#pragma unroll
        for (int ks = 0; ks < 4; ++ks)
#pragma unroll
            for (int j = 0; j < 8; ++j) y[ks][j] *= rstd * A.qgain[16 * ks + 8 * hh + j];
        if (lat) {
            const int t = A.tq0 + wrow + r32; const float prow = (float)(t >> 6), pcol = (float)(t & 63);
#pragma unroll
            for (int j = 0; j < 8; ++j) { const float inv = exp2f(-(float)(8 * hh + j) * (13.287712379549449f / 16.0f));
                const float ar = prow * inv, ac = pcol * inv; const float cr = __cosf(ar), sr = __sinf(ar), cc = __cosf(ac), sc = __sinf(ac);
                const float a1 = y[0][j], a2 = y[2][j]; y[0][j] = a1 * cr - a2 * sr; y[2][j] = a2 * cr + a1 * sr;
                const float b1 = y[1][j], b2 = y[3][j]; y[1][j] = b1 * cc - b2 * sc; y[3][j] = b2 * cc + b1 * sc; }
        }
#pragma unroll
        for (int ks = 0; ks < 4; ++ks) { v4u pk; pk.x = cvt_pk_bf16(y[ks][0] * QSCALE, y[ks][1] * QSCALE); pk.y = cvt_pk_bf16(y[ks][2] * QSCALE, y[ks][3] * QSCALE);
            pk.z = cvt_pk_bf16(y[ks][4] * QSCALE, y[ks][5] * QSCALE); pk.w = cvt_pk_bf16(y[ks][6] * QSCALE, y[ks][7] * QSCALE); qf[ks] = __builtin_bit_cast(bf16x8, pk); }
    }
    const int tq = lat ? A.tq0 + wrow + r32 : 0;

    f32x16 o[NDT];
#pragma unroll
    for (int dt = 0; dt < NDT; ++dt)
#pragma unroll
        for (int r = 0; r < 16; ++r) o[dt][r] = 0.f;
    const f32x16 zero16 = {0.f, 0.f, 0.f, 0.f, 0.f, 0.f, 0.f, 0.f, 0.f, 0.f, 0.f, 0.f, 0.f, 0.f, 0.f, 0.f};
    float lsum = 0.f;

    const int nt = (lat ? A.nlat : 0) + 4;
    v4u kreg[NLD], vreg[NLD];
#define ATT_SRC(ii) const int i_ = (ii); const bool loc = lat && i_ < A.nlat; const int j_ = loc ? (A.kt0 + i_) : (i_ - (lat ? A.nlat : 0));
#define ATT_LOAD_K(ii) do { ATT_SRC(ii) \
        const bf16* kb = A.zq + (size_t)((loc ? A.krow_lat : A.krow_ctx) + 64 * j_) * ZP + A.kcol; \
        _Pragma("unroll") for (int n = 0; n < NLD; ++n) { const int c = tid + 512 * n; kreg[n] = *(const v4u*)(kb + (size_t)(c / KCH) * ZP + (c % KCH) * 8); } } while (0)
#define ATT_LOAD_V(ii) do { ATT_SRC(ii) \
        const bf16* vb = (loc ? A.vt_lat : A.vt_ctx) + 64 * j_; const int vpt = loc ? T : CT; \
        _Pragma("unroll") for (int n = 0; n < NLD; ++n) { const int c = tid + 512 * n; vreg[n] = *(const v4u*)(vb + (size_t)(c >> 3) * vpt + (c & 7) * 8); } } while (0)
#define ATT_WRITE_K(st) do { LAS unsigned char* Kw = lds + (st) * STAGE; \
        _Pragma("unroll") for (int n = 0; n < NLD; ++n) { const int c = tid + 512 * n; *(LAS v4u*)(Kw + (c / KCH) * KROWB + (c % KCH) * 16) = kreg[n]; } } while (0)
#define ATT_WRITE_V(st) do { LAS unsigned char* Vw = lds + (st) * STAGE + KSZ; \
        _Pragma("unroll") for (int n = 0; n < NLD; ++n) { const int c = tid + 512 * n; { LAS v2u* vw_ = (LAS v2u*)(Vw + (c >> 3) * VRS + ((c & 7) >> 1) * 32 + (c & 1) * 8); v2u a_; a_.x = vreg[n].x; a_.y = vreg[n].y; v2u b_; b_.x = vreg[n].z; b_.y = vreg[n].w; vw_[0] = a_; vw_[2] = b_; }     } } while (0)
#define ATT_LOAD_TILE(ii) do { ATT_LOAD_K(ii); ATT_LOAD_V(ii); } while (0)
#define ATT_WRITE_TILE(st) do { ATT_WRITE_K(st); ATT_WRITE_V(st); } while (0)

#define ATT_EXP8(P, base, koff) do { _Pragma("unroll") for (int r = (base); r < (base) + 8; ++r) { float e_ = __builtin_amdgcn_exp2f(P[r]); \
        if (MODE == 1) { if (msk) { const int dlt = kv0m + (koff) + (r & 3) + 8 * (r >> 2); if (dlt > 128 || dlt < -128) e_ = 0.f; } } \
        P[r] = e_; lsum += e_; } } while (0)
#define ATT_VFRAG(dst, dt_, s__) do { dst = *(const LAS bf16x8*)(vp + (dt_) * 32 * VRS + 32 * (s__)); } while (0)
#define ATT_STEP(C0, C1, N0, N1, ii, PRE) do { const int i_s = (ii); const bool more = (PRE) || (i_s + 2 < nt); const bool more3 = (PRE) || (i_s + 3 < nt); \
        const LAS unsigned char* kpn = lds + st_nxt * STAGE + r32 * KROWB + khalf + 16 * hh; \
        const LAS unsigned char* vp = lds + st_cur * STAGE + KSZ + r32 * VRS + 16 * hh; \
        const int jd_ = (A.kt0 + i_s) - (A.tq0 >> 6); const bool msk = (MODE == 1) && lat && (i_s < A.nlat) && (jd_ == -2 || jd_ == 2);     const int kv0m = 64 * (A.kt0 + i_s) + 4 * hh - tq; \
        { const bf16x8 a0 = *(const LAS bf16x8*)(kpn); const bf16x8 a1 = *(const LAS bf16x8*)(kpn + 32 * KROWB); \
          N0 = __builtin_amdgcn_mfma_f32_32x32x16_bf16(a0, qf[0], zero16, 0, 0, 0); N1 = __builtin_amdgcn_mfma_f32_32x32x16_bf16(a1, qf[0], zero16, 0, 0, 0); } \
        ATT_EXP8(C0, 0, 0); \
        { const bf16x8 a0 = *(const LAS bf16x8*)(kpn + 32); const bf16x8 a1 = *(const LAS bf16x8*)(kpn + 32 * KROWB + 32); \
          N0 = __builtin_amdgcn_mfma_f32_32x32x16_bf16(a0, qf[1], N0, 0, 0, 0); N1 = __builtin_amdgcn_mfma_f32_32x32x16_bf16(a1, qf[1], N1, 0, 0, 0); } \
        ATT_EXP8(C0, 8, 0); \
        { const bf16x8 a0 = *(const LAS bf16x8*)(kpn + 64); const bf16x8 a1 = *(const LAS bf16x8*)(kpn + 32 * KROWB + 64); \
          N0 = __builtin_amdgcn_mfma_f32_32x32x16_bf16(a0, qf[2], N0, 0, 0, 0); N1 = __builtin_amdgcn_mfma_f32_32x32x16_bf16(a1, qf[2], N1, 0, 0, 0); } \
        ATT_EXP8(C1, 0, 32); \
        { const bf16x8 a0 = *(const LAS bf16x8*)(kpn + 96); const bf16x8 a1 = *(const LAS bf16x8*)(kpn + 32 * KROWB + 96); \
          N0 = __builtin_amdgcn_mfma_f32_32x32x16_bf16(a0, qf[3], N0, 0, 0, 0); N1 = __builtin_amdgcn_mfma_f32_32x32x16_bf16(a1, qf[3], N1, 0, 0, 0); } \
        ATT_EXP8(C1, 8, 32); \
        if (more) { ATT_WRITE_K(st_wr); } if (more3) { ATT_LOAD_K(i_s + 3); } \
        bf16x8 vf[2][NDT]; \
        _Pragma("unroll") for (int dt = 0; dt < NDT; ++dt) { ATT_VFRAG(vf[0][dt], dt, 0); } \
        bf16x8 pa[4]; \
        { v4u t0, t1, t2, t3; \
          t0.x = cvt_pk_bf16(C0[0], C0[1]); t0.y = cvt_pk_bf16(C0[2], C0[3]); t0.z = cvt_pk_bf16(C0[4], C0[5]); t0.w = cvt_pk_bf16(C0[6], C0[7]); \
          t1.x = cvt_pk_bf16(C0[8], C0[9]); t1.y = cvt_pk_bf16(C0[10], C0[11]); t1.z = cvt_pk_bf16(C0[12], C0[13]); t1.w = cvt_pk_bf16(C0[14], C0[15]); \
          t2.x = cvt_pk_bf16(C1[0], C1[1]); t2.y = cvt_pk_bf16(C1[2], C1[3]); t2.z = cvt_pk_bf16(C1[4], C1[5]); t2.w = cvt_pk_bf16(C1[6], C1[7]); \
          t3.x = cvt_pk_bf16(C1[8], C1[9]); t3.y = cvt_pk_bf16(C1[10], C1[11]); t3.z = cvt_pk_bf16(C1[12], C1[13]); t3.w = cvt_pk_bf16(C1[14], C1[15]); \
          pa[0] = __builtin_bit_cast(bf16x8, t0); pa[1] = __builtin_bit_cast(bf16x8, t1); pa[2] = __builtin_bit_cast(bf16x8, t2); pa[3] = __builtin_bit_cast(bf16x8, t3); } \
        _Pragma("unroll") for (int s_ = 0; s_ < 4; ++s_) { \
            if (s_ < 3) { _Pragma("unroll") for (int dt = 0; dt < NDT; ++dt) { ATT_VFRAG(vf[(s_ + 1) & 1][dt], dt, s_ + 1); } } \
            _Pragma("unroll") for (int dt = 0; dt < NDT; ++dt) o[dt] = __builtin_amdgcn_mfma_f32_32x32x16_bf16(pa[s_], vf[s_ & 1][dt], o[dt], 0, 0, 0); } \
        if (more) { ATT_WRITE_V(st_wr); } if (more3) { ATT_LOAD_V(i_s + 3); } \
        __syncthreads(); \
        { const int t_ = st_cur; st_cur = st_nxt; st_nxt = st_wr; st_wr = t_; } } while (0)

    int st_cur = 0, st_nxt = 1, st_wr = 2;
    ATT_LOAD_TILE(0); ATT_WRITE_TILE(0); ATT_LOAD_TILE(1); ATT_WRITE_TILE(1); __syncthreads();
    ATT_LOAD_TILE(2);
    f32x16 cA0, cA1, cB0, cB1;
    {
        const LAS unsigned char* kp = lds + r32 * KROWB + khalf + 16 * hh;
#pragma unroll
        for (int ks = 0; ks < 4; ++ks) {
            const bf16x8 a0 = *(const LAS bf16x8*)(kp + 32 * ks);
            const bf16x8 a1 = *(const LAS bf16x8*)(kp + 32 * KROWB + 32 * ks);
            if (ks == 0) { cA0 = __builtin_amdgcn_mfma_f32_32x32x16_bf16(a0, qf[0], zero16, 0, 0, 0); cA1 = __builtin_amdgcn_mfma_f32_32x32x16_bf16(a1, qf[0], zero16, 0, 0, 0); }
            else { cA0 = __builtin_amdgcn_mfma_f32_32x32x16_bf16(a0, qf[ks], cA0, 0, 0, 0); cA1 = __builtin_amdgcn_mfma_f32_32x32x16_bf16(a1, qf[ks], cA1, 0, 0, 0); }
        }
    }
    int i = 0;
    for (; i + 4 < nt; i += 2) {
        ATT_STEP(cA0, cA1, cB0, cB1, i, true);
        ATT_STEP(cB0, cB1, cA0, cA1, i + 1, true);
    }
    for (; i < nt; i += 2) {
        ATT_STEP(cA0, cA1, cB0, cB1, i, false);
        if (i + 1 < nt) ATT_STEP(cB0, cB1, cA0, cA1, i + 1, false);
    }
#undef ATT_STEP
#undef ATT_VFRAG
#undef ATT_EXP8

    LAS float* lsm = (LAS float*)(lds + LSM_OFF);
    {
    int t3 = tid_in; asm volatile("" : "+v"(t3)); const int r32 = t3 & 31, hh = (t3 >> 5) & 1;
    float lt = xsum32(lsum);
    if (MODE == 1) lt += __builtin_amdgcn_exp2f(A.sink[A.hq0 + (w >> 1)] * LOG2E);
    if (hh == 0) lsm[w * 32 + r32] = lt;
    __syncthreads();
    if (MODE == 1) {
        LAS bf16* ost = (LAS bf16*)lds;
#pragma unroll
        for (int r = 0; r < 16; ++r) { const int q = crow(r, hh); const float f = __builtin_amdgcn_rcpf(lsm[w * 32 + q]);
#pragma unroll
            for (int dt = 0; dt < NDT; ++dt) ost[(wrow + q) * 264 + (w >> 1) * 64 + 32 * dt + r32] = (bf16)(cvt_pk_bf16(o[dt][r] * f, 0.f) & 0xffffu); }
        __syncthreads();
        { const int te = w * 64 + (t3 & 63);
#pragma unroll
          for (int n = 0; n < 4; ++n) { const int c = te + 512 * n, row = c >> 5, ch = c & 31;
              *(v4u*)(A.yo + (size_t)(A.qrow0 + row) * YW + A.ycol0 + ch * 8) = *(const LAS v4u*)((LAS unsigned char*)lds + row * 528 + ch * 16); } }
        __syncthreads();
    } else {
        LAS float* Xb = (LAS float*)lds;
        if (w >= 4) {
#pragma unroll
            for (int r = 0; r < 16; ++r) { const int q = crow(r, hh); const float f = -A.lam * __builtin_amdgcn_rcpf(lsm[w * 32 + q]);
#pragma unroll
                for (int dt = 0; dt < NDT; ++dt) Xb[(wrow + q) * XB_STRIDE + 32 * dt + r32] = o[dt][r] * f; }
        }
        __syncthreads();
        if (w < 4) {
            LAS bf16* ost = (LAS bf16*)(lds + 66560);
            float sl[NDT];
#pragma unroll
            for (int dt = 0; dt < NDT; ++dt) sl[dt] = A.subln[32 * dt + r32] * A.oscale;
#pragma unroll
            for (int r = 0; r < 16; ++r) { const int q = crow(r, hh); const float f = __builtin_amdgcn_rcpf(lsm[w * 32 + q]);
                float v[NDT]; float ss = 0.f;
#pragma unroll
                for (int dt = 0; dt < NDT; ++dt) { v[dt] = o[dt][r] * f + Xb[(wrow + q) * XB_STRIDE + 32 * dt + r32]; ss += v[dt] * v[dt]; }
                ss += swz_xor<1>(ss); ss += swz_xor<2>(ss); ss += swz_xor<4>(ss); ss += swz_xor<8>(ss); ss += swz_xor<16>(ss);
                const float rstd = rsqrtf(ss * (1.0f / 128.0f) + EPS);
#pragma unroll
                for (int dt = 0; dt < NDT; ++dt) ost[(wrow + q) * 136 + 32 * dt + r32] = (bf16)(cvt_pk_bf16(v[dt] * rstd * sl[dt], 0.f) & 0xffffu); }
        }
        __syncthreads();
        { const int te = w * 64 + (t3 & 63);
#pragma unroll
          for (int n = 0; n < 4; ++n) { const int c = te + 512 * n, row = c >> 4, ch = c & 15;
              *(v4u*)(A.yo + (size_t)(A.qrow0 + row) * YW + A.ycol0 + ch * 8) = *(const LAS v4u*)(lds + 66560 + row * 272 + ch * 16); } }
        __syncthreads();
    }
    }
}
#undef ATT_LOAD_TILE
#undef ATT_WRITE_TILE
#undef ATT_LOAD_K
#undef ATT_LOAD_V
#undef ATT_WRITE_K
#undef ATT_WRITE_V
#undef ATT_SRC
}


namespace mg {
constexpr int BK = 32, RS = 80, TILE_B = 256 * RS, STG = 2 * TILE_B;

template <int ACT  > struct EpiStore {
    bf16* O; int ldc;
    __device__ __forceinline__ void operator()(const f32x16 (&acc)[4][2], const pg8::Unit& u, int wm, int wn, int r32, int hh) const {
#pragma unroll
        for (int mi = 0; mi < 4; ++mi) { bf16* rowp = O + (size_t)(u.pm * 256 + wm * 128 + mi * 32 + r32) * ldc + u.pn * 256 + wn * 64 + 4 * hh;
#pragma unroll
            for (int ni = 0; ni < 2; ++ni)
#pragma unroll
                for (int g = 0; g < 4; ++g) { float v[4];
#pragma unroll
                    for (int e = 0; e < 4; ++e) { float x = acc[mi][ni][4 * g + e];
                        if (ACT == 1) x = pg8::act_sigmoid(x);
                        if (ACT == 2) { x = fmaxf(x, 0.f); x = x * x; }
                        v[e] = x; }
                    v2u w; w.x = cvt_pk_bf16(v[0], v[1]); w.y = cvt_pk_bf16(v[2], v[3]);
                    *(v2u*)(rowp + ni * 32 + 8 * g) = w; } }
    }
};
struct EpiGate {
    bf16* G; int ldc;
    __device__ __forceinline__ void operator()(const f32x16 (&acc)[4][2], const pg8::Unit& u, int wm, int wn, int r32, int hh) const {
#pragma unroll
        for (int mi = 0; mi < 4; ++mi) { bf16* rowp = G + (size_t)(u.pm * 256 + wm * 128 + mi * 32 + r32) * ldc + u.pn * 256 + wn * 64 + 4 * hh;
#pragma unroll
            for (int ni = 0; ni < 2; ++ni)
#pragma unroll
                for (int g = 0; g < 4; ++g) { const v2u q = *(const v2u*)(rowp + ni * 32 + 8 * g);
                    v2u w; w.x = cvt_pk_bf16(acc[mi][ni][4 * g] * bf_lo(q.x), acc[mi][ni][4 * g + 1] * bf_hi(q.x)); w.y = cvt_pk_bf16(acc[mi][ni][4 * g + 2] * bf_lo(q.y), acc[mi][ni][4 * g + 3] * bf_hi(q.y));
                    *(v2u*)(rowp + ni * 32 + 8 * g) = w; } }
    }
};
struct EpiResid {
    const float* res_lat; const float* res_ctx; float* out_lat; float* out_ctx; const float* modg;
    __device__ __forceinline__ void operator()(const f32x16 (&acc)[4][2], const pg8::Unit& u, int wm, int wn, int r32, int hh) const {
        const int r0 = u.pm * 256; const bool lat = r0 < MLAT;
        const float* res = lat ? res_lat : res_ctx - (size_t)MLAT * D; float* out = lat ? out_lat : out_ctx - (size_t)MLAT * D;
        const float* mg_ = modg + (size_t)(lat ? (r0 / T) : NB) * 6144 + u.pn * 256 + wn * 64 + 4 * hh;
#pragma unroll
        for (int ni = 0; ni < 2; ++ni)
#pragma unroll
            for (int g = 0; g < 4; ++g) { const f32x4 gv = *(const f32x4*)(mg_ + ni * 32 + 8 * g);
#pragma unroll
                for (int mi = 0; mi < 4; ++mi) { const size_t ro = (size_t)(r0 + wm * 128 + mi * 32 + r32) * D + u.pn * 256 + wn * 64 + 4 * hh + ni * 32 + 8 * g;
                    const f32x4 r = *(const f32x4*)(res + ro);
                    f32x4 a; a.x = acc[mi][ni][4 * g]; a.y = acc[mi][ni][4 * g + 1]; a.z = acc[mi][ni][4 * g + 2]; a.w = acc[mi][ni][4 * g + 3];
                    *(f32x4*)(out + ro) = r + gv * a; } }
    }
};

template <class Epi>
__device__ __forceinline__ void gemm(LAS unsigned char* lds, const int tid, const pg8::Gemm g, const pg8::StaticOrder& S, const Epi& E) {
    const int lane = tid & 63, r32 = lane & 31, hh = lane >> 5;
    const int w = __builtin_amdgcn_readfirstlane(tid >> 6), wm = w >> 2, wn = w & 3;
    const int nk = g.K / BK;
    const int lrow = tid >> 2, lkc = tid & 3;
    pg8::Unit u;
    for (int ui = 0; S.next(ui, u); ++ui) {
        const bf16* Ab = g.A + (size_t)u.pm * 256 * g.lda + (g.agrp ? (size_t)(u.pn / g.agrp) * g.agstride : (size_t)0) + (size_t)lrow * g.lda + lkc * 8;
        const bf16* Bb = g.Bt + (size_t)u.pn * 256 * g.ldb + (size_t)lrow * g.ldb + lkc * 8;
        f32x16 acc[4][2];
#pragma unroll
        for (int mi = 0; mi < 4; ++mi)
#pragma unroll
            for (int ni = 0; ni < 2; ++ni)
#pragma unroll
                for (int r = 0; r < 16; ++r) acc[mi][ni][r] = 0.f;
        v4u ar[2], br[2];
#define MG_LOAD(kt_) do { const int ko = (kt_) * BK; \
        ar[0] = *(const v4u*)(Ab + ko); ar[1] = *(const v4u*)(Ab + (size_t)128 * g.lda + ko); \
        br[0] = *(const v4u*)(Bb + ko); br[1] = *(const v4u*)(Bb + (size_t)128 * g.ldb + ko); } while (0)
#define MG_WRITE(st_) do { LAS unsigned char* Aw = lds + (st_) * STG + lrow * RS + lkc * 16; \
        *(LAS v4u*)(Aw) = ar[0]; *(LAS v4u*)(Aw + 128 * RS) = ar[1]; \
        *(LAS v4u*)(Aw + TILE_B) = br[0]; *(LAS v4u*)(Aw + TILE_B + 128 * RS) = br[1]; } while (0)
        MG_LOAD(0); MG_WRITE(0); __syncthreads();
        for (int kt = 0; kt < nk; ++kt) {
            if (kt + 1 < nk) MG_LOAD(kt + 1);
            const LAS unsigned char* As = lds + (kt & 1) * STG + (wm * 128 + r32) * RS + 16 * hh;
            const LAS unsigned char* Bs = lds + (kt & 1) * STG + TILE_B + (wn * 64 + r32) * RS + 16 * hh;
#pragma unroll
            for (int ks = 0; ks < 2; ++ks) {
                bf16x8 af[4], bq[2];
#pragma unroll
                for (int mi = 0; mi < 4; ++mi) af[mi] = *(const LAS bf16x8*)(As + mi * 32 * RS + 32 * ks);
#pragma unroll
                for (int ni = 0; ni < 2; ++ni) bq[ni] = *(const LAS bf16x8*)(Bs + ni * 32 * RS + 32 * ks);
#pragma unroll
                for (int mi = 0; mi < 4; ++mi)
#pragma unroll
                    for (int ni = 0; ni < 2; ++ni) acc[mi][ni] = __builtin_amdgcn_mfma_f32_32x32x16_bf16(bq[ni], af[mi], acc[mi][ni], 0, 0, 0);
            }
            if (kt + 1 < nk) MG_WRITE((kt + 1) & 1);
            __syncthreads();
        }
#undef MG_LOAD
#undef MG_WRITE
        E(acc, u, wm, wn, r32, hh);
    }
}
}


#define XB_TMO      128
#define XB_XCNT(j)  (256  + 64 * (j))
#define XB_XSUB(j)  (1280 + 64 * (j))
#define XB_XGEN(j)  (2304 + 64 * (j))
#define XB_TOP      3328
#define XB_TOPGEN   3392
#define XCD_BAR_WORDS 3456
#define XB_SPIN_CAP (1u << 18)

__device__ __forceinline__ unsigned xb_ld(unsigned* p)              { return __hip_atomic_load(p, __ATOMIC_RELAXED, __HIP_MEMORY_SCOPE_AGENT); }
__device__ __forceinline__ unsigned xb_add(unsigned* p, unsigned v) { return __hip_atomic_fetch_add(p, v, __ATOMIC_RELAXED, __HIP_MEMORY_SCOPE_AGENT); }
__device__ __forceinline__ unsigned xb_xcc_id() { return (unsigned)__builtin_amdgcn_s_getreg((3 << 11) | 20) & 0xFu; }
#define XB_SPIN(cond, bar) do { unsigned _sp = 0; while (cond) { __builtin_amdgcn_s_sleep(1); \
    if ((++_sp & 255u) == 0u) { if (xb_ld(&(bar)[XB_TMO])) break; if (_sp > XB_SPIN_CAP) { atomicAdd(&(bar)[XB_TMO], 1u); break; } } } } while (0)

struct XcdBarrier {
    unsigned* bar; unsigned x;
    volatile LAS unsigned* st;
};

__device__ __forceinline__ XcdBarrier xcd_barrier_post(unsigned* bar, volatile LAS unsigned* st) {
    XcdBarrier b; b.bar = bar; b.x = xb_xcc_id(); b.st = st;
    if (threadIdx.x == 0) (void)xb_add(&bar[XB_XCNT(b.x)], 1u);
    return b;
}
__device__ __forceinline__ void xcd_barrier_complete(unsigned* bar, unsigned x, unsigned& nloc, unsigned& nx) {
    const unsigned G = gridDim.x * gridDim.y * gridDim.z;
    unsigned sum, cnt, mine, sp = 0u;
    for (;;) {
        sum = 0u; cnt = 0u; mine = 0u;
#pragma unroll
        for (unsigned j = 0; j < 16; ++j) { const unsigned c = xb_ld(&bar[XB_XCNT(j)]); sum += c; cnt += (c > 0u) ? 1u : 0u; mine = (j == x) ? c : mine; }
        if (sum == G) break;
        __builtin_amdgcn_s_sleep(1);
        if ((++sp & 255u) == 0u) { if (xb_ld(&bar[XB_TMO])) break; if (sp > XB_SPIN_CAP) { atomicAdd(&bar[XB_TMO], 1u); break; } }
    }
    nloc = mine > 0u ? mine : 1u; nx = cnt > 0u ? cnt : 1u;
}

__device__ __forceinline__ void xcd_barrier(const XcdBarrier& b, const bool is_t0) {
    asm volatile("s_waitcnt vmcnt(0)" ::: "memory");
    __syncthreads();
    if (is_t0) {
        unsigned* bar = b.bar;
        __builtin_amdgcn_s_waitcnt(0);
        unsigned nloc = b.st[0], nx = b.st[1];
        if (nloc == 0u) { xcd_barrier_complete(bar, b.x, nloc, nx); b.st[0] = nloc; b.st[1] = nx; }
        const unsigned old = xb_add(&bar[XB_XSUB(b.x)], 1u);
        const unsigned gen = old / nloc;
        if (old + 1u == (gen + 1u) * nloc) {
            __builtin_amdgcn_fence(__ATOMIC_RELEASE, "agent");
            asm volatile("s_waitcnt vmcnt(0)" ::: "memory");
            const unsigned og = xb_add(&bar[XB_TOP], 1u);
            const unsigned tg = og / nx;
            if (og + 1u == (tg + 1u) * nx) xb_add(&bar[XB_TOPGEN], 1u);
            else XB_SPIN(xb_ld(&bar[XB_TOPGEN]) == tg, bar);
            __builtin_amdgcn_fence(__ATOMIC_ACQUIRE, "agent");
            xb_add(&bar[XB_XGEN(b.x)], 1u);
            asm volatile("s_waitcnt vmcnt(0)" ::: "memory");
        } else {
            XB_SPIN(xb_ld(&bar[XB_XGEN(b.x)]) == gen, bar);
            __builtin_amdgcn_fence(__ATOMIC_ACQUIRE, "agent");
            asm volatile("s_waitcnt vmcnt(0)" ::: "memory");
        }
    }
    __syncthreads();
}

struct Args {
    const float* in[24]; float* out; unsigned char* ws;
    int ph_lo, ph_hi;
};
struct Frame {
    LAS unsigned char* lds; int tid, lane, wave, G, vcu, gw, NGW, bx;
};

__device__ __forceinline__ void tr_item(const float* W, int ldw, int Nsub, bf16* WT, int ldt, LAS float* scr, int item, int lane) {
    const int nblk = Nsub / 32, kb = item / nblk, nb = item % nblk, k0 = 64 * kb, n0 = 32 * nb;
#pragma unroll 8
    for (int i = 0; i < 32; ++i) { const int kk = 2 * i + (lane >> 5); scr[kk * 33 + (lane & 31)] = W[(size_t)(k0 + kk) * ldw + n0 + (lane & 31)]; }
    asm volatile("s_waitcnt lgkmcnt(0)" ::: "memory");
    const int c = lane & 7;
#pragma unroll
    for (int j = 0; j < 4; ++j) { const int n = (lane >> 3) + 8 * j; const LAS float* s = scr + (8 * c) * 33 + n;
        v4u o; o.x = cvt_pk_bf16(s[0 * 33], s[1 * 33]); o.y = cvt_pk_bf16(s[2 * 33], s[3 * 33]); o.z = cvt_pk_bf16(s[4 * 33], s[5 * 33]); o.w = cvt_pk_bf16(s[6 * 33], s[7 * 33]);
        *(v4u*)(WT + (size_t)(n0 + n) * ldt + k0 + 8 * c) = o; }
    asm volatile("s_waitcnt lgkmcnt(0)" ::: "memory");
}

__device__ __forceinline__ void norm_mod_rows(const Frame& F, const float* xlat, const float* xctx, const float* gain, const float* modl, int ch_shift, int ch_scale, bf16* XN) {
#pragma unroll 2
    for (int r = F.gw; r < MTOT; r += F.NGW) {
        const bool lat = r < MLAT; const float* xrow = lat ? xlat + (size_t)r * D : xctx + (size_t)(r - MLAT) * D;
        const float* mb = modl + (size_t)(lat ? r / T : NB) * 6144;
        const f32x4* xr = (const f32x4*)xrow + F.lane;
        f32x4 v[4]; float s = 0.f;
#pragma unroll
        for (int j = 0; j < 4; ++j) { v[j] = xr[64 * j]; s += (v[j].x * v[j].x + v[j].y * v[j].y) + (v[j].z * v[j].z + v[j].w * v[j].w); }
        const float rstd = rsqrtf(wave_sum(s) * (1.f / D) + EPS);
        v2u* o8 = (v2u*)(XN + (size_t)r * D) + F.lane;
#pragma unroll
        for (int j = 0; j < 4; ++j) { const int c = 4 * F.lane + 256 * j;
            const f32x4 g = *(const f32x4*)(gain + c), sh = *(const f32x4*)(mb + ch_shift * 1024 + c), sc = *(const f32x4*)(mb + ch_scale * 1024 + c);
            const f32x4 y = v[j] * rstd * g * (sc + 1.0f) + sh;
            v2u pk; pk.x = cvt_pk_bf16(y.x, y.y); pk.y = cvt_pk_bf16(y.z, y.w); o8[64 * j] = pk; }
    }
}


template <int KIND>
__device__ __forceinline__ void simple_gemm(const Frame& F, const bf16* A, int lda, int agrp_cols, int agstride, const bf16* Bt, int ldb, int M, int N, int K,
                                            bf16* O, int ldc, const float* res_lat_, const float* res_ctx_, float* out_lat_, float* out_ctx_, const float* modg) {
    const int r32 = F.lane & 31, hh = F.lane >> 5; const int ntn = N / 32, ntiles = (M / 32) * ntn;
    for (int tt = F.gw; tt < ntiles; tt += F.NGW) {
        const int tm = tt / ntn, tn = tt % ntn;
        const int aoff = agrp_cols ? ((tn * 32) / agrp_cols) * agstride : 0;
        const bf16* ap = A + (size_t)(tm * 32 + r32) * lda + aoff + 8 * hh;
        const bf16* bp = Bt + (size_t)(tn * 32 + r32) * ldb + 8 * hh;
        f32x16 acc;
#pragma unroll
        for (int r = 0; r < 16; ++r) acc[r] = 0.f;
        for (int k0 = 0; k0 < K; k0 += 16) {
            const bf16x8 a = *(const bf16x8*)(ap + k0), b = *(const bf16x8*)(bp + k0);
            acc = __builtin_amdgcn_mfma_f32_32x32x16_bf16(a, b, acc, 0, 0, 0);
        }
        const int col = tn * 32 + r32;
#pragma unroll
        for (int r = 0; r < 16; ++r) { const int row = tm * 32 + (r & 3) + 8 * (r >> 2) + 4 * hh; float v = acc[r];
            if (KIND == 1) v = pg8::act_sigmoid(v);
            if (KIND == 2) { v = fmaxf(v, 0.f); v = v * v; }
            if (KIND <= 2) O[(size_t)row * ldc + col] = (bf16)(cvt_pk_bf16(v, 0.f) & 0xffffu);
            if (KIND == 3) { bf16* gp = O + (size_t)row * ldc + col; *gp = (bf16)(cvt_pk_bf16(v * bf1(*gp), 0.f) & 0xffffu); }
            if (KIND == 4) { const bool lat = row < MLAT; const int bidx = lat ? row / T : NB;
                const float* rp = lat ? res_lat_ + (size_t)row * D : res_ctx_ + (size_t)(row - MLAT) * D; float* op = lat ? out_lat_ + (size_t)row * D : out_ctx_ + (size_t)(row - MLAT) * D;
                op[col] = rp[col] + modg[(size_t)bidx * 6144 + col] * v; } }
    }
}

__global__ void __launch_bounds__(NWAVES * 64, 2) fwd_mega(Args args) {
    extern __shared__ __attribute__((aligned(16))) unsigned char lds_raw[];
    cg::grid_group grid = cg::this_grid();
    Frame F;
    F.lds = (LAS unsigned char*)lds_raw;
    F.tid = threadIdx.x; F.lane = F.tid & 63; F.wave = __builtin_amdgcn_readfirstlane(F.tid >> 6);
    const int wave_s = __builtin_amdgcn_readfirstlane((int)threadIdx.x >> 6);
    F.G = gridDim.x; { const int bx = blockIdx.x; F.vcu = (F.G % 8 == 0) ? (bx % 8) * (F.G / 8) + bx / 8 : bx; }
    F.gw = blockIdx.x * NWAVES + F.wave; F.NGW = F.G * NWAVES;
    volatile LAS unsigned* xb_st = (volatile LAS unsigned*)(F.lds + 132096);
    if (threadIdx.x == 0) { xb_st[0] = 0u; xb_st[1] = 0u; }
    __syncthreads();
    XcdBarrier bar = xcd_barrier_post((unsigned*)(args.ws + WS_CTL) + 4096, xb_st);
    if (args.ph_hi < 0) grid.sync();
#define AS4 __attribute__((address_space(4)))
#define INP(i) (*(const float* const AS4*)(kp + 8 * (i)))
#define ws (*(unsigned char* const AS4*)(kp + 200))
#define out (*(float* const AS4*)(kp + 192))
#define x_in INP(0)
#define c_in INP(1)
#define ctx_in INP(2)
#define cctx_in INP(3)
#define w_ada INP(4)
#define b_ada INP(5)
#define norm1 INP(6)
#define norm2 INP(7)
#define w_in INP(8)
#define w_pool INP(9)
#define pool_scale INP(10)
#define swa_qn INP(11)
#define swa_kn INP(12)
#define swa_sink INP(13)
#define diff_qn INP(14)
#define diff_kn INP(15)
#define diff_lambda INP(16)
#define diff_subln INP(17)
#define w_br_pool INP(18)
#define w_br_swa INP(19)
#define w_br_diff INP(20)
#define w_out INP(21)
#define w_ff1 INP(22)
#define w_ff2 INP(23)
#define mod ((float*)(ws + WS_MOD))
#define lamv ((float*)(ws + WS_LAM))
#define XC ((float*)(ws + WS_XC))
#define XN ((bf16*)(ws + WS_XN))
#define Y ((bf16*)(ws + WS_Y))
#define Z1 ((bf16*)(ws + WS_BIG + BO_Z1))
#define VT ((bf16*)(ws + WS_BIG + BO_VT))
#define GB ((bf16*)(ws + WS_BIG + BO_G))
#define MG ((bf16*)(ws + WS_BIG + BO_MG))
#define HB ((bf16*)(ws + WS_BIG + BO_H))
#define wl (ws + WS_W + (size_t)l * WL_STRIDE)
#define modl (mod + (size_t)l * 5 * 6144)
#define res_lat (l == 0 ? x_in : (const float*)out)
#define res_ctx (l == 0 ? ctx_in : (const float*)XC)
    int ph = 0;
    const int lo = args.ph_lo, hi = args.ph_hi;
#define PH_BEGIN if (lo <= ph && ph < hi) { const AS4 char* kp = (const AS4 char*)__builtin_amdgcn_kernarg_segment_ptr(); asm volatile("" : "+s"(kp)); \
    { int tid_ = wave_s * 64 + (int)__builtin_amdgcn_mbcnt_hi(~0u, __builtin_amdgcn_mbcnt_lo(~0u, 0u)); asm volatile("" : "+v"(tid_)); F.tid = tid_; F.lane = tid_ & 63; F.wave = __builtin_amdgcn_readfirstlane(tid_ >> 6); int bx_ = blockIdx.x; asm volatile("" : "+s"(bx_)); int G_ = gridDim.x; asm volatile("" : "+s"(G_)); F.bx = bx_; F.G = G_; F.vcu = (G_ % 8 == 0) ? (bx_ % 8) * (G_ / 8) + bx_ / 8 : bx_; F.gw = bx_ * NWAVES + F.wave; F.NGW = G_ * NWAVES; }
#define PH_END(dosync) if ((dosync) && ph + 1 < hi) { xcd_barrier(bar, F.tid == 0); } } ++ph;

    PH_BEGIN
    {
        LAS float* sc = (LAS float*)F.lds;
        LAS float* part = sc + 5 * 1024;
        if (F.bx < 192) {
            for (int i = F.tid; i < 5 * 1024; i += 512) { const int v = i >> 10, k = i & 1023; const float cv = v < NB ? c_in[v * D + k] : cctx_in[k]; sc[i] = cv / (1.0f + __expf(-cv)); }
            __syncthreads();
            for (int it = F.bx; it < 192; it += F.G) {
                const int l = it / 96, n = (it % 96) * 64 + F.lane;
                const float* wp = w_ada + (size_t)l * D * 6144 + (size_t)(F.wave * 128) * 6144 + n;
                float a0 = 0.f, a1 = 0.f, a2 = 0.f, a3 = 0.f, a4 = 0.f;
#pragma unroll 8
                for (int k = 0; k < 128; ++k) { const float wv = wp[(size_t)k * 6144]; const int kk = F.wave * 128 + k;
                    a0 += sc[kk] * wv; a1 += sc[1024 + kk] * wv; a2 += sc[2048 + kk] * wv; a3 += sc[3072 + kk] * wv; a4 += sc[4096 + kk] * wv; }
                part[(F.wave * 5 + 0) * 64 + F.lane] = a0; part[(F.wave * 5 + 1) * 64 + F.lane] = a1; part[(F.wave * 5 + 2) * 64 + F.lane] = a2;
                part[(F.wave * 5 + 3) * 64 + F.lane] = a3; part[(F.wave * 5 + 4) * 64 + F.lane] = a4;
                __syncthreads();
                if (F.tid < 320) { const int v = F.tid >> 6, ln = F.tid & 63; float s = 0.f;
#pragma unroll
                    for (int wv = 0; wv < 8; ++wv) s += part[(wv * 5 + v) * 64 + ln];
                    const int nn = (it % 96) * 64 + ln; mod[((size_t)l * 5 + v) * 6144 + nn] = s + b_ada[(size_t)l * 6144 + nn]; }
                __syncthreads();
            }
        }
        __syncthreads();
        if (F.gw == F.NGW - 1) {
            for (int l = 0; l < NL; ++l) { const float* dl = diff_lambda + (size_t)l * 256;
                const float s1 = wave_sum(dl[F.lane] * dl[64 + F.lane]), s2 = wave_sum(dl[128 + F.lane] * dl[192 + F.lane]);
                const float lam_init = 0.8f - 0.6f * expf(-0.3f * (float)l);
                if (F.lane == 0) lamv[l] = expf(s1) - expf(s2) + lam_init;
                float gq = fabsf(diff_qn[l * 64 + F.lane]), gk = fabsf(diff_kn[l * 64 + F.lane]), sq = fabsf(swa_qn[l * 64 + F.lane]), sk = fabsf(swa_kn[l * 64 + F.lane]);
                gq = wave_max(gq); gk = wave_max(gk); sq = wave_max(sq); sk = wave_max(sk);
                if (F.lane == 0) { lamv[8 + 2 * l] = 64.0f * QSCALE * gq * gk * 1.01f + 0.25f; lamv[8 + 2 * l + 1] = 64.0f * QSCALE * sq * sk * 1.01f + 0.25f; } }
        }
        LAS float* scr = (LAS float*)(F.lds + 32768 + F.wave * 8704);
        constexpr int I_IN1 = 16 * (N1 / 32), I_G = 16 * (NG / 32), I_BR = 8 * 32, I_OUT = 16 * 32, I_1 = 16 * (FF / 32), I_2 = 64 * 32;
        constexpr int I_LAYER = I_IN1 + I_G + 2 * I_BR + I_OUT + I_1 + I_2;
        for (int it = F.gw; it < NL * I_LAYER; it += F.NGW) {
            const int l = it / I_LAYER; int r = it % I_LAYER;
            if (r < I_IN1) { tr_item(w_in + (size_t)l * D * DIN, DIN, N1, (bf16*)(wl + WO_IN1), D, scr, r, F.lane); continue; } r -= I_IN1;
            if (r < I_G) { tr_item(w_in + (size_t)l * D * DIN + N1, DIN, NG, (bf16*)(wl + WO_G), D, scr, r, F.lane); continue; } r -= I_G;
            if (r < I_BR) { tr_item(w_br_swa + (size_t)l * 512 * D, D, D, (bf16*)(wl + WO_BR) + (size_t)1024 * 512, 512, scr, r, F.lane); continue; } r -= I_BR;
            if (r < I_BR) { tr_item(w_br_diff + (size_t)l * 512 * D, D, D, (bf16*)(wl + WO_BR) + (size_t)2048 * 512, 512, scr, r, F.lane); continue; } r -= I_BR;
            if (r < I_OUT) { tr_item(w_out + (size_t)l * D * D, D, D, (bf16*)(wl + WO_OUT), D, scr, r, F.lane); continue; } r -= I_OUT;
            if (r < I_1) { tr_item(w_ff1 + (size_t)l * D * FF, FF, FF, (bf16*)(wl + WO_1), D, scr, r, F.lane); continue; } r -= I_1;
            tr_item(w_ff2 + (size_t)l * FF * D, D, D, (bf16*)(wl + WO_2), FF, scr, r, F.lane);
        }
        for (int it = F.gw; it < NL * 512; it += F.NGW) {
            const int l = it / 512, k = it % 512, g = k >> 7, i = k & 127;
            const float* wp = w_pool + ((size_t)(l * 4 + g) * 128 + i) * 128; const float* ps = pool_scale + (size_t)l * 512 + g * 128;
            const float* wb = w_br_pool + (size_t)l * 512 * D + (size_t)(g * 128) * D + F.lane;
            float acc[16];
#pragma unroll
            for (int p = 0; p < 16; ++p) acc[p] = 0.f;
            for (int j = 0; j < 128; ++j) { const float a = wp[j] * ps[j];
#pragma unroll
                for (int p = 0; p < 16; ++p) acc[p] += a * wb[(size_t)j * D + p * 64]; }
            bf16* wt = (bf16*)(ws + WS_W + (size_t)l * WL_STRIDE + WO_BR);
#pragma unroll
            for (int p = 0; p < 16; ++p) wt[(size_t)(p * 64 + F.lane) * 512 + k] = (bf16)(cvt_pk_bf16(acc[p], 0.f) & 0xffffu);
        }
    }
    PH_END(true)

    PH_BEGIN
    norm_mod_rows(F, x_in, ctx_in, norm1, mod, 0, 1, XN);
    PH_END(true)

    for (int l = 0; l < NL; ++l) {
        const int MEFF = (l + 1 < NL) ? MTOT : MLAT;

        PH_BEGIN
#ifdef SG_P1
        simple_gemm<0>(F, XN, D, 0, 0, (const bf16*)(wl + WO_IN1), D, MTOT, N1, D, Z1, N1, nullptr, nullptr, nullptr, nullptr, nullptr);
#else
        { pg8::Gemm g{XN, (const bf16*)(wl + WO_IN1), MTOT, N1, D, D, D, 0, 0}; pg8::StaticOrder S; S.init(MTOT, N1, F.G, F.bx);
          pg8::EpiStore<0> E{Z1, N1};
          pg8::gemm_phase<pg8::EpiStore<0>, pg8::StaticOrder, true, true>(F.lds, F.tid, g, S, E); }
#endif
        PH_END(true)

        PH_BEGIN
        {
            const float* kn_s = swa_kn + l * 64; const float* kn_d = diff_kn + l * 64;
            {
                const int sub = F.lane >> 3, c = F.lane & 7;
                float inv8[8];
#pragma unroll
                for (int j = 0; j < 8; ++j) inv8[j] = exp2f(-(float)(8 * (c & 1) + j) * (13.287712379549449f / 16.0f));
                for (int q0 = 8 * F.gw; q0 < MTOT * 10; q0 += 8 * F.NGW) {
                    const int q = q0 + sub, r = q / 10, hd = q - r * 10;
                    const bool lat = r < MLAT;
                    const int col = (hd < 2 ? C_KS + hd * 64 : C_KD + (hd - 2) * 64) + 8 * c;
                    const float* gp = (hd < 2 ? kn_s : kn_d) + 8 * c;
                    bf16* zp = Z1 + (size_t)r * N1 + col;
                    const v4u raw = *(const v4u*)zp;
                    float y[8];
                    y[0] = bf_lo(raw.x); y[1] = bf_hi(raw.x); y[2] = bf_lo(raw.y); y[3] = bf_hi(raw.y); y[4] = bf_lo(raw.z); y[5] = bf_hi(raw.z); y[6] = bf_lo(raw.w); y[7] = bf_hi(raw.w);
                    float ss = 0.f;
#pragma unroll
                    for (int j = 0; j < 8; ++j) ss += y[j] * y[j];
                    ss += swz_xor<1>(ss); ss += swz_xor<2>(ss); ss += swz_xor<4>(ss);
                    const float rstd = rsqrtf(ss * (1.f / 64.f) + EPS);
                    const f32x4 g0 = *(const f32x4*)gp, g1 = *(const f32x4*)(gp + 4);
                    y[0] *= rstd * g0.x; y[1] *= rstd * g0.y; y[2] *= rstd * g0.z; y[3] *= rstd * g0.w; y[4] *= rstd * g1.x; y[5] *= rstd * g1.y; y[6] *= rstd * g1.z; y[7] *= rstd * g1.w;
                    if (lat) {
                        const int t = r & (T - 1); const float pos = ((c & 3) < 2) ? (float)(t >> 6) : (float)(t & 63);
#pragma unroll
                        for (int j = 0; j < 8; ++j) { const float yp = swz_xor<4>(y[j]); const float ang = pos * inv8[j]; const float cs = __cosf(ang), sn = __sinf(ang);
                            y[j] = (c < 4) ? (y[j] * cs - yp * sn) : (y[j] * cs + yp * sn); }
                    }
                    v4u o; o.x = cvt_pk_bf16(y[0], y[1]); o.y = cvt_pk_bf16(y[2], y[3]); o.z = cvt_pk_bf16(y[4], y[5]); o.w = cvt_pk_bf16(y[6], y[7]);
                    *(v4u*)zp = o;
                }
            }
            LAS bf16* S = (LAS bf16*)(F.lds + F.wave * 8448);
            for (int it = F.gw; it < 528 * 10; it += F.NGW) {
                const int rb = it / 10, cgp = it % 10; const bool lat = rb < 512;
                const int b = lat ? rb >> 7 : (rb - 512) >> 2, t0 = lat ? (rb & 127) * 64 : ((rb - 512) & 3) * 64;
                const int row0 = lat ? b * T + t0 : MLAT + b * CT + t0; const int pitch = lat ? T : CT;
                int col0; bf16* dst;
                if (cgp < 2) { col0 = C_VS + cgp * 64; dst = VT + (lat ? VT_VS_LAT : VT_VS_CTX) / 2 + (size_t)((b * 2 + cgp) * 64) * pitch + t0; }
                else { const int h = (cgp - 2) >> 1, dh = (cgp - 2) & 1; col0 = C_VD + h * 128 + dh * 64; dst = VT + (lat ? VT_VD_LAT : VT_VD_CTX) / 2 + (size_t)((b * 4 + h) * 128 + dh * 64) * pitch + t0; }
#pragma unroll
                for (int i = 0; i < 8; ++i) { const int tl = i * 8 + (F.lane >> 3), ch = F.lane & 7;
                    const v4u v = *(const v4u*)(Z1 + (size_t)(row0 + tl) * N1 + col0 + ch * 8);
                    LAS unsigned* sp = (LAS unsigned*)(S + tl * 66 + ch * 8); sp[0] = v.x; sp[1] = v.y; sp[2] = v.z; sp[3] = v.w; }
                asm volatile("s_waitcnt lgkmcnt(0)" ::: "memory");
#pragma unroll
                for (int i = 0; i < 8; ++i) { const int d = i * 8 + (F.lane >> 3), tc = F.lane & 7; const LAS bf16* sp = S + (tc * 8) * 66 + d;
                    v4u o; o.x = (unsigned)sp[0] | ((unsigned)sp[66] << 16); o.y = (unsigned)sp[2 * 66] | ((unsigned)sp[3 * 66] << 16);
                    o.z = (unsigned)sp[4 * 66] | ((unsigned)sp[5 * 66] << 16); o.w = (unsigned)sp[6 * 66] | ((unsigned)sp[7 * 66] << 16);
                    *(v4u*)(dst + (size_t)d * pitch + tc * 8) = o; }
                asm volatile("s_waitcnt lgkmcnt(0)" ::: "memory");
            }
            for (int rb = F.gw; rb < 2112; rb += F.NGW) {
                const bool lat = rb < 2048;
                const int b = lat ? rb >> 9 : (rb - 2048) >> 4, t0 = lat ? (rb & 511) * 16 : ((rb - 2048) & 15) * 16;
                const int s0 = lat ? b * T : MLAT + b * CT, n = lat ? T : CT;
                const int hw = 1 << (F.lane >> 4);
                const bf16* ub = Z1 + (size_t)s0 * N1 + C_U + F.lane * 8;
                float Sm[8];
#pragma unroll
                for (int e = 0; e < 8; ++e) Sm[e] = 0.f;
#define POOL_ACC(ti, sgn) do { const v4u q_ = *(const v4u*)(ub + (size_t)(ti) * N1); \
                    Sm[0] += (sgn) * bf_lo(q_.x); Sm[1] += (sgn) * bf_hi(q_.x); Sm[2] += (sgn) * bf_lo(q_.y); Sm[3] += (sgn) * bf_hi(q_.y); \
                    Sm[4] += (sgn) * bf_lo(q_.z); Sm[5] += (sgn) * bf_hi(q_.z); Sm[6] += (sgn) * bf_lo(q_.w); Sm[7] += (sgn) * bf_hi(q_.w); } while (0)
                { const int i0 = max(t0 - hw, 0), i1 = min(t0 + hw - 1, n - 1);
                  for (int i = i0; i <= i1; ++i) POOL_ACC(i, 1.0f); }
#pragma unroll 4
                for (int t = t0; t < t0 + 16; ++t) {
                    const float rc = 1.0f / (float)(min(t + hw, n) - max(t - hw, 0));
                    const v4u q = *(const v4u*)(ub + (size_t)t * N1);
                    v4u o; o.x = cvt_pk_bf16(Sm[0] * rc - bf_lo(q.x), Sm[1] * rc - bf_hi(q.x)); o.y = cvt_pk_bf16(Sm[2] * rc - bf_lo(q.y), Sm[3] * rc - bf_hi(q.y));
                    o.z = cvt_pk_bf16(Sm[4] * rc - bf_lo(q.z), Sm[5] * rc - bf_hi(q.z)); o.w = cvt_pk_bf16(Sm[6] * rc - bf_lo(q.w), Sm[7] * rc - bf_hi(q.w));
                    *(v4u*)(Y + (size_t)(s0 + t) * YW + F.lane * 8) = o;
                    if (t + hw <= n - 1) POOL_ACC(t + hw, 1.0f);
                    if (t - hw >= 0) POOL_ACC(t - hw, -1.0f);
                }
#undef POOL_ACC
            }
        }
        PH_END(true)

        PH_BEGIN
        {
            const float M2d = lamv[8 + 2 * l], M2s = lamv[8 + 2 * l + 1];
            const float lam = lamv[l], lam_init = 0.8f - 0.6f * expf(-0.3f * (float)l);
            att::UnitArgs A;
            A.zq = Z1; A.yo = Y; A.sinkl2 = 0.f; A.sink = swa_sink + l * 8; A.lam = lam; A.oscale = 1.0f - lam_init; A.subln = diff_subln + l * 128;
            const int nu = (l + 1 < NL) ? 1024 + 32 : 1024;
            for (int u = F.vcu; u < nu; u += F.G) {
                const bool lq = u < 1024; const int v = u - 1024;
                const int b = lq ? (u >> 8) : (v >> 3), h = lq ? ((u >> 6) & 3) : ((v >> 1) & 3), qb = lq ? (u & 63) : (v & 1);
                A.vt_lat = VT + VT_VD_LAT / 2 + (size_t)((b * 4 + h) * 128) * T; A.vt_ctx = VT + VT_VD_CTX / 2 + (size_t)((b * 4 + h) * 128) * CT;
                A.qgain = diff_qn + l * 64; A.qrow0 = lq ? b * T + qb * 128 : MLAT + b * CT + qb * 128; A.tq0 = lq ? qb * 128 : -1; A.krow_lat = b * T; A.krow_ctx = MLAT + b * CT;
                A.kcol = C_KD + h * 128; A.qcol0 = C_QD + h * 128; A.ycol0 = 1024 + h * 128; A.kt0 = 0; A.nlat = lq ? T / 64 : 0; A.M2 = M2d; A.hq0 = 0;
                att::attn_unit<0>(F.lds, F.tid, A);
            }
            for (int u = F.vcu; u < nu; u += F.G) {
                const bool lq = u < 1024; const int v = u - 1024;
                const int b = lq ? (u >> 8) : (v >> 3), kvh = lq ? ((u >> 7) & 1) : ((v >> 2) & 1), qb = lq ? (u & 127) : (v & 3);
                A.vt_lat = VT + VT_VS_LAT / 2 + (size_t)((b * 2 + kvh) * 64) * T; A.vt_ctx = VT + VT_VS_CTX / 2 + (size_t)((b * 2 + kvh) * 64) * CT;
                A.qgain = swa_qn + l * 64; A.qrow0 = lq ? b * T + qb * 64 : MLAT + b * CT + qb * 64; A.tq0 = lq ? qb * 64 : -1; A.krow_lat = b * T; A.krow_ctx = MLAT + b * CT;
                A.kcol = C_KS + kvh * 64; A.qcol0 = C_QS + kvh * 256; A.ycol0 = 512 + kvh * 256;
                const int k0 = max(qb - 2, 0), k1 = min(qb + 2, T / 64 - 1); A.kt0 = lq ? k0 : 0; A.nlat = lq ? k1 - k0 + 1 : 0; A.M2 = M2s; A.hq0 = kvh * 4;
                att::attn_unit<1>(F.lds, F.tid, A);
            }
        }
        PH_END(true)

        PH_BEGIN
#ifdef SG_P3A
        simple_gemm<1>(F, XN, D, 0, 0, (const bf16*)(wl + WO_G), D, MTOT, NG, D, GB, NG, nullptr, nullptr, nullptr, nullptr, nullptr);
#else
        { pg8::Gemm g{XN, (const bf16*)(wl + WO_G), MEFF, NG, D, D, D, 0, 0}; pg8::StaticOrder S; S.init(MEFF, NG, F.G, F.bx);
          pg8::EpiStore<1> E{GB, NG};
          pg8::gemm_phase<pg8::EpiStore<1>, pg8::StaticOrder, true, true>(F.lds, F.tid, g, S, E); }
#endif
        PH_END(true)

        PH_BEGIN
#ifdef SG_P3
        simple_gemm<3>(F, Y, YW, 1024, 512, (const bf16*)(wl + WO_BR), 512, MTOT, NG, 512, GB, NG, nullptr, nullptr, nullptr, nullptr, nullptr);
#else
        { pg8::Gemm g{Y, (const bf16*)(wl + WO_BR), MEFF, NG, 512, YW, 512, 4, 512}; pg8::StaticOrder S; S.init(MEFF, NG, F.G, F.bx);
          pg8::EpiGate E{GB, NG};
          pg8::gemm_phase<pg8::EpiGate, pg8::StaticOrder, true, true>(F.lds, F.tid, g, S, E); }
#endif
        PH_END(true)

        PH_BEGIN
#pragma unroll 4
        for (size_t i = (size_t)F.bx * 512 + F.tid; i < (size_t)MEFF * 128; i += (size_t)F.G * 512) {
            const size_t r = i >> 7; const int c = (int)(i & 127) * 8; const bf16* gp = GB + r * NG + c;
            const v4u a = *(const v4u*)gp, b = *(const v4u*)(gp + 1024), d = *(const v4u*)(gp + 2048);
            v4u o; o.x = cvt_pk_bf16(bf_lo(a.x) + bf_lo(b.x) + bf_lo(d.x), bf_hi(a.x) + bf_hi(b.x) + bf_hi(d.x)); o.y = cvt_pk_bf16(bf_lo(a.y) + bf_lo(b.y) + bf_lo(d.y), bf_hi(a.y) + bf_hi(b.y) + bf_hi(d.y));
            o.z = cvt_pk_bf16(bf_lo(a.z) + bf_lo(b.z) + bf_lo(d.z), bf_hi(a.z) + bf_hi(b.z) + bf_hi(d.z)); o.w = cvt_pk_bf16(bf_lo(a.w) + bf_lo(b.w) + bf_lo(d.w), bf_hi(a.w) + bf_hi(b.w) + bf_hi(d.w));
            *(v4u*)(MG + r * D + c) = o;
        }
        PH_END(true)

        PH_BEGIN
#ifdef SG_P4
        simple_gemm<4>(F, MG, D, 0, 0, (const bf16*)(wl + WO_OUT), D, MTOT, D, D, nullptr, 0, res_lat, res_ctx, out, XC, modl + 2 * 1024);
#else
        { pg8::Gemm g{MG, (const bf16*)(wl + WO_OUT), MEFF, D, D, D, D, 0, 0}; pg8::StaticOrder S; S.init(MEFF, D, F.G, F.bx);
          pg8::EpiResid E{res_lat, res_ctx, out, XC, modl + 2 * 1024};
          pg8::gemm_phase<pg8::EpiResid, pg8::StaticOrder, true, true>(F.lds, F.tid, g, S, E); }
#endif
        PH_END(true)

        PH_BEGIN
        norm_mod_rows(F, out, XC, norm2 + l * D, modl, 3, 4, XN);
        PH_END(true)

        PH_BEGIN
#ifdef SG_P5
        simple_gemm<2>(F, XN, D, 0, 0, (const bf16*)(wl + WO_1), D, MTOT, FF, D, HB, FF, nullptr, nullptr, nullptr, nullptr, nullptr);
#else
        { pg8::Gemm g{XN, (const bf16*)(wl + WO_1), MEFF, FF, D, D, D, 0, 0}; pg8::StaticOrder S; S.init(MEFF, FF, F.G, F.bx);
          pg8::EpiStore<2> E{HB, FF};
          pg8::gemm_phase<pg8::EpiStore<2>, pg8::StaticOrder, true, true>(F.lds, F.tid, g, S, E); }
#endif
        PH_END(true)

        PH_BEGIN
#ifdef SG_P6
        simple_gemm<4>(F, HB, FF, 0, 0, (const bf16*)(wl + WO_2), FF, MTOT, D, FF, nullptr, 0, out, XC, out, XC, modl + 5 * 1024);
#else
        { pg8::Gemm g{HB, (const bf16*)(wl + WO_2), MEFF, D, FF, FF, FF, 0, 0}; pg8::StaticOrder S; S.init(MEFF, D, F.G, F.bx);
          pg8::EpiResid E{out, XC, out, XC, modl + 5 * 1024};
          pg8::gemm_phase<pg8::EpiResid, pg8::StaticOrder, true, true>(F.lds, F.tid, g, S, E); }
#endif
        PH_END(l + 1 < NL)

        if (l + 1 < NL) {
            PH_BEGIN
            norm_mod_rows(F, out, XC, norm1 + (l + 1) * D, mod + (size_t)(l + 1) * 5 * 6144, 0, 1, XN);
            PH_END(true)
        }
    }
#undef PH_BEGIN
#undef PH_END
}

#undef AS4
#undef INP
#undef ws
#undef out
#undef x_in
#undef c_in
#undef ctx_in
#undef cctx_in
#undef w_ada
#undef b_ada
#undef norm1
#undef norm2
#undef w_in
#undef w_pool
#undef pool_scale
#undef swa_qn
#undef swa_kn
#undef swa_sink
#undef diff_qn
#undef diff_kn
#undef diff_lambda
#undef diff_subln
#undef w_br_pool
#undef w_br_swa
#undef w_br_diff
#undef w_out
#undef w_ff1
#undef w_ff2
#undef mod
#undef lamv
#undef XC
#undef XN
#undef Y
#undef Z1
#undef VT
#undef GB
#undef MG
#undef HB
#undef wl
#undef modl
#undef res_lat
#undef res_ctx
extern "C" void kernel_launch(void* const* d_in, const int* in_sizes, int n_in, void* d_out, int out_size, void* d_ws, size_t ws_size, hipStream_t stream) {
    static int grid = 0;
    if (grid == 0) {
        if (n_in != 24 || in_sizes[0] != MLAT * D || out_size != MLAT * D || ws_size < WS_END) {
            fprintf(stderr, "kernel_launch: unexpected shapes / workspace (n_in %d, in0 %d, out %d, ws %zu, need %zu); nothing launched\n", n_in, n_in > 0 ? in_sizes[0] : -1, out_size, ws_size, (size_t)WS_END); grid = -1; return; }
        int dev = 0, cus = 0, per_cu = 0;
        if (hipGetDevice(&dev) != hipSuccess || hipDeviceGetAttribute(&cus, hipDeviceAttributeMultiprocessorCount, dev) != hipSuccess) { grid = -1; return; }
        if (hipFuncSetAttribute((const void*)fwd_mega, hipFuncAttributeMaxDynamicSharedMemorySize, LDS_BYTES) != hipSuccess) { fprintf(stderr, "kernel_launch: hipFuncSetAttribute failed\n"); grid = -1; return; }
        if (hipOccupancyMaxActiveBlocksPerMultiprocessor(&per_cu, (const void*)fwd_mega, NWAVES * 64, LDS_BYTES) != hipSuccess || per_cu < 1) { fprintf(stderr, "kernel_launch: occupancy query says %d\n", per_cu); per_cu = 1; }
        (void)hipGetLastError();
        grid = cus * 1;
    }
    if (grid < 0) return;
    if (hipMemsetAsync((char*)d_ws + WS_CTL, 0, 1 << 20, stream) != hipSuccess) { fprintf(stderr, "kernel_launch: memset failed\n"); return; }
    Args a{};
    for (int i = 0; i < 24; ++i) a.in[i] = (const float*)d_in[i];
    a.out = (float*)d_out; a.ws = (unsigned char*)d_ws; a.ph_lo = 0; a.ph_hi = 1000;
    void* kargs[] = {&a};
    hipError_t e = hipLaunchCooperativeKernel((void*)fwd_mega, dim3(grid), dim3(NWAVES * 64), kargs, LDS_BYTES, stream);
    if (e != hipSuccess) fprintf(stderr, "cooperative launch failed: %s (grid %d)\n", hipGetErrorString(e), grid);
}
```

```cpp
#include <hip/hip_runtime.h>
#include <hip/hip_cooperative_groups.h>
#include <cstdio>
#include <cstdint>
#include <type_traits>
namespace cg = cooperative_groups;

constexpr int NB = 4, T = 8192, D = 1024, NL = 2, CT = 256, FF = 4096;
constexpr int MLAT = NB * T, MCTX = NB * CT, MTOT = MLAT + MCTX;
constexpr int DIN = 5888, N1 = 2816, NG = 3072, YW = 1536;
constexpr int C_U = 0, C_QS = 512, C_KS = 1024, C_VS = 1152, C_QD = 1280, C_KD = 1792, C_VD = 2304;
constexpr float EPS = 1e-6f;
constexpr float QSCALE = 0.125f * 1.4426950408889634f;
constexpr float LOG2E = 1.4426950408889634f;

constexpr size_t MiB = 1u << 20;
constexpr size_t WS_CTL = 0;
constexpr size_t WS_MOD = 1 * MiB;
constexpr size_t WS_LAM = 1 * MiB + 512 * 1024;
constexpr size_t WS_W = 2 * MiB, WL_STRIDE = 33 * MiB;
constexpr size_t WO_IN1 = 0, WO_G = 5 * MiB + 512 * 1024, WO_BR = 11 * MiB + 512 * 1024, WO_OUT = 14 * MiB + 512 * 1024, WO_1 = 16 * MiB + 512 * 1024, WO_2 = 24 * MiB + 512 * 1024;
constexpr size_t WS_XC = 68 * MiB;
constexpr size_t WS_XN = 72 * MiB;
constexpr size_t WS_Y = 138 * MiB;
constexpr size_t WS_BIG = 237 * MiB;
constexpr size_t BO_Z1 = 0, BO_VT = 182 * MiB, BO_G = 0, BO_MG = 198 * MiB, BO_H = 0;
constexpr size_t VT_VS_LAT = 0, VT_VD_LAT = 8 * MiB, VT_VS_CTX = 40 * MiB, VT_VD_CTX = 40 * MiB + 256 * 1024;
constexpr size_t WS_END = 501 * MiB;
static_assert((size_t)MTOT * N1 * 2 <= BO_VT && BO_VT + 42 * MiB <= 264 * MiB && (size_t)MTOT * NG * 2 <= BO_MG && BO_MG + (size_t)MTOT * D * 2 <= 264 * MiB && (size_t)MTOT * FF * 2 <= 264 * MiB, "BIG map");
static_assert(WS_XN + (size_t)MTOT * D * 2 <= WS_Y && WS_Y + (size_t)MTOT * YW * 2 <= WS_BIG && WS_BIG + 264 * MiB <= WS_END, "ws map");

constexpr int LDS_BYTES = 147456;
constexpr int NWAVES = 8;

#define LAS __attribute__((address_space(3)))
typedef unsigned short bf16;
typedef unsigned v4u __attribute__((ext_vector_type(4)));
typedef unsigned v2u __attribute__((ext_vector_type(2)));
typedef float f32x4 __attribute__((ext_vector_type(4)));
typedef float f32x16 __attribute__((ext_vector_type(16)));
typedef short bf16x8 __attribute__((ext_vector_type(8)));
typedef short s16x4 __attribute__((ext_vector_type(4)));

typedef float f32x2_t __attribute__((ext_vector_type(2))); typedef __bf16 bf16x2_t __attribute__((ext_vector_type(2)));
__device__ __forceinline__ unsigned cvt_pk_bf16(float lo, float hi) { f32x2_t v = {lo, hi}; bf16x2_t b = __builtin_convertvector(v, bf16x2_t); return __builtin_bit_cast(unsigned, b); }
__device__ __forceinline__ float bf_lo(unsigned u) { return __builtin_bit_cast(float, u << 16); }
__device__ __forceinline__ float bf_hi(unsigned u) { return __builtin_bit_cast(float, u & 0xffff0000u); }
__device__ __forceinline__ float bf1(bf16 h) { return __builtin_bit_cast(float, (unsigned)h << 16); }
template <int X> __device__ __forceinline__ float swz_xor(float v) { return __builtin_bit_cast(float, __builtin_amdgcn_ds_swizzle(__builtin_bit_cast(int, v), (X << 10) | 0x1f)); }
__device__ __forceinline__ float xsum32(float v) { const unsigned u = __builtin_bit_cast(unsigned, v); auto rr = __builtin_amdgcn_permlane32_swap(u, u, false, false); return __builtin_bit_cast(float, (unsigned)rr[0]) + __builtin_bit_cast(float, (unsigned)rr[1]); }
__device__ __forceinline__ float xmax32(float v) { const unsigned u = __builtin_bit_cast(unsigned, v); auto rr = __builtin_amdgcn_permlane32_swap(u, u, false, false); return fmaxf(__builtin_bit_cast(float, (unsigned)rr[0]), __builtin_bit_cast(float, (unsigned)rr[1])); }
__device__ __forceinline__ float xget32(float v, bool lower_half) { const unsigned u = __builtin_bit_cast(unsigned, v); auto rr = __builtin_amdgcn_permlane32_swap(u, u, false, false); return lower_half ? __builtin_bit_cast(float, (unsigned)rr[1]) : __builtin_bit_cast(float, (unsigned)rr[0]); }
__device__ __forceinline__ float wave_sum(float v) { v += swz_xor<1>(v); v += swz_xor<2>(v); v += swz_xor<4>(v); v += swz_xor<8>(v); v += swz_xor<16>(v); return xsum32(v); }
__device__ __forceinline__ float wave_max(float v) { v = fmaxf(v, swz_xor<1>(v)); v = fmaxf(v, swz_xor<2>(v)); v = fmaxf(v, swz_xor<4>(v)); v = fmaxf(v, swz_xor<8>(v)); v = fmaxf(v, swz_xor<16>(v)); return xmax32(v); }

namespace pg8 {
#define PG8_LAS __attribute__((address_space(3)))
typedef unsigned short bf16_t;
typedef short bf16x8 __attribute__((ext_vector_type(8)));
typedef float f32x4 __attribute__((ext_vector_type(4)));
typedef unsigned u32x4 __attribute__((ext_vector_type(4)));
constexpr int BM = 256, BK = 64, HALF = 128, HTB = HALF * BK * 2  , STAGE_BYTES = 8 * HTB, NXCD = 8, WGM = 8;

__host__ __device__ __forceinline__ int lds_byte(int r, int c) { const int st = (r >> 4) * 2 + (c >> 5), rr = r & 15, cc = c & 31, ob = rr * 64 + cc * 2; return st * 1024 + (ob ^ (((ob >> 9) & 1) << 5)); }
__host__ __device__ __forceinline__ void stage_rc(int b, int& R, int& C) { const int st = b / 1024, sb = b % 1024, swz = sb ^ (((sb >> 9) & 1) << 5); R = (st >> 1) * 16 + swz / 64; C = (st & 1) * 32 + (swz % 64) / 2; }
__host__ __device__ __forceinline__ int perm32(int rho) { const int n = rho >> 4, i = rho & 15; return 8 * (i >> 2) + 4 * n + (i & 3); }

struct Unit { int pm, pn; };
struct Gemm { const bf16_t* A; const bf16_t* Bt; int M, N, K, lda, ldb, agrp, agstride; };

struct StaticOrder {
    int nM, nN, nwg, G, c;
    __host__ __device__ void init(int M, int N, int G_, int c_) { nM = M / BM; nN = N / BM; nwg = nM * nN; G = G_; c = c_; }
    __host__ __device__ bool next(int i, Unit& u) const {
        const long L = (long)i * G + c; if (L >= nwg) return false;
        int wgid = (int)L; { const int q = nwg / NXCD, r = nwg % NXCD, xcd = wgid % NXCD, off = wgid / NXCD; wgid = (xcd < r ? xcd * (q + 1) : r * (q + 1) + (xcd - r) * q) + off; }
        const int nig = WGM * nN, gid = wgid / nig, fm = gid * WGM, gsz = (nM - fm) < WGM ? (nM - fm) : WGM;
        u.pm = fm + ((wgid % nig) % gsz); u.pn = (wgid % nig) / gsz; return true;
    }
    __device__ __forceinline__ void a_ready(const Unit&) const {}
    __device__ __forceinline__ void done(const Unit&) const {}
};


__device__ __forceinline__ float act_sigmoid(float v) { return __builtin_amdgcn_rcpf(1.0f + __builtin_amdgcn_exp2f(-v * 1.4426950408889634f)); }
template <int ACT  > struct EpiStore {
    static constexpr bool PERM = true, AFTER_DRAIN = false;
    bf16_t* O; int ldc;
    __device__ __forceinline__ void operator()(const f32x4 (&acc)[2][2][4][2], const Unit& u, int wr, int wc, int fr, int fq) const {
        const int row0 = u.pm * BM + wr * 64 + fr, col0 = u.pn * BM + wc * 32 + 8 * fq;
#pragma unroll
        for (int ai = 0; ai < 2; ++ai)
#pragma unroll
            for (int m = 0; m < 4; ++m) { bf16_t* rowp = O + (size_t)(row0 + ai * HALF + m * 16) * ldc + col0;
#pragma unroll
                for (int bj = 0; bj < 2; ++bj) { f32x4 v0 = acc[ai][bj][m][0], v1 = acc[ai][bj][m][1];
                    if (ACT == 1) {
#pragma unroll
                        for (int e = 0; e < 4; ++e) { v0[e] = act_sigmoid(v0[e]); v1[e] = act_sigmoid(v1[e]); } }
                    if (ACT == 2) {
#pragma unroll
                        for (int e = 0; e < 4; ++e) { const float a = fmaxf(v0[e], 0.f), b = fmaxf(v1[e], 0.f); v0[e] = a * a; v1[e] = b * b; } }
                    u32x4 w; w.x = cvt_pk_bf16(v0[0], v0[1]); w.y = cvt_pk_bf16(v0[2], v0[3]); w.z = cvt_pk_bf16(v1[0], v1[1]); w.w = cvt_pk_bf16(v1[2], v1[3]);
                    *(u32x4*)(rowp + bj * HALF) = w; } }
    }
};
struct EpiGate {
    static constexpr bool PERM = true, AFTER_DRAIN = false;
    bf16_t* G; int ldc;
    __device__ __forceinline__ void operator()(const f32x4 (&acc)[2][2][4][2], const Unit& u, int wr, int wc, int fr, int fq) const {
        const int row0 = u.pm * BM + wr * 64 + fr, col0 = u.pn * BM + wc * 32 + 8 * fq;
#pragma unroll
        for (int ai = 0; ai < 2; ++ai)
#pragma unroll
            for (int m = 0; m < 4; ++m) { bf16_t* rowp = G + (size_t)(row0 + ai * HALF + m * 16) * ldc + col0;
#pragma unroll
                for (int bj = 0; bj < 2; ++bj) { const f32x4 v0 = acc[ai][bj][m][0], v1 = acc[ai][bj][m][1];
                    const u32x4 g = *(const u32x4*)(rowp + bj * HALF);
                    u32x4 w; w.x = cvt_pk_bf16(v0[0] * bf_lo(g.x), v0[1] * bf_hi(g.x)); w.y = cvt_pk_bf16(v0[2] * bf_lo(g.y), v0[3] * bf_hi(g.y));
                    w.z = cvt_pk_bf16(v1[0] * bf_lo(g.z), v1[1] * bf_hi(g.z)); w.w = cvt_pk_bf16(v1[2] * bf_lo(g.w), v1[3] * bf_hi(g.w));
                    *(u32x4*)(rowp + bj * HALF) = w; } }
    }
};
struct EpiResid {
    static constexpr bool PERM = true, AFTER_DRAIN = false;
    const float* res_lat; const float* res_ctx; float* out_lat; float* out_ctx; const float* modg;
    __device__ __forceinline__ void operator()(const f32x4 (&acc)[2][2][4][2], const Unit& u, int wr, int wc, int fr, int fq) const {
        const int r0 = u.pm * BM; const bool lat = r0 < MLAT;
        const float* res = lat ? res_lat : res_ctx - (size_t)MLAT * D; float* out = lat ? out_lat : out_ctx - (size_t)MLAT * D;
        const int bidx = lat ? (r0 / T) : NB;
        const int row0 = r0 + wr * 64 + fr, col0 = u.pn * BM + wc * 32 + 8 * fq;
        f32x4 gv[2][2];
#pragma unroll
        for (int bj = 0; bj < 2; ++bj)
#pragma unroll
            for (int n = 0; n < 2; ++n) gv[bj][n] = *(const f32x4*)(modg + (size_t)bidx * 6144 + col0 + bj * HALF + 4 * n);
#pragma unroll
        for (int ai = 0; ai < 2; ++ai)
#pragma unroll
            for (int m = 0; m < 4; ++m) { const size_t ro = (size_t)(row0 + ai * HALF + m * 16) * D + col0;
#pragma unroll
                for (int bj = 0; bj < 2; ++bj)
#pragma unroll
                    for (int n = 0; n < 2; ++n) { const f32x4 r = *(const f32x4*)(res + ro + bj * HALF + 4 * n);
                        *(f32x4*)(out + ro + bj * HALF + 4 * n) = r + gv[bj][n] * acc[ai][bj][m][n]; } }
    }
};

template <class Epi, class Sched, bool ALIGN_EPI = false, bool SP2 = false>
__device__ __forceinline__ void gemm_phase(PG8_LAS unsigned char* lds, const int tid, const Gemm g, const Sched& S, const Epi& E) {
    const int wid = __builtin_amdgcn_readfirstlane(tid >> 6), lane = tid & 63, wr = wid >> 2, wc = wid & 3, fr = lane & 15, fq = lane >> 4;
    const int K = g.K, nt = K / BK;
    unsigned voffA[2], voffB[2];
#pragma unroll
    for (int i = 0; i < 2; ++i) { int R, C; stage_rc(tid * 16 + i * 8192, R, C); const int Rb = Epi::PERM ? ((R & ~31) + perm32(R & 31)) : R;
        voffA[i] = (unsigned)(R * g.lda + C) * 2u; voffB[i] = (unsigned)(Rb * g.ldb + C) * 2u; }
    const size_t kstep = (size_t)(BK * 2);
    const size_t hstepA = (size_t)HALF * g.lda * 2, hstepB = (size_t)HALF * g.ldb * 2;
    const size_t tstepA = 2 * hstepA, tstepB = 2 * hstepB;
#define PG8_ABASE(u) ((const char*)g.A + (size_t)(u).pm * tstepA + (g.agrp ? (size_t)((u).pn / g.agrp) * (size_t)g.agstride * 2 : (size_t)0))
#define PG8_BBASE(u) ((const char*)g.Bt + (size_t)(u).pn * tstepB)
    const unsigned ldsw = (unsigned)wid * 1024u;
    const int aoff = lds_byte(wr * 64 + fr, fq * 8), boff = lds_byte(wc * 32 + fr, fq * 8);
#define PG8_SA(b, h) (((b) * 2 + (h)) * HTB)
#define PG8_SB(b, h) ((4 + (b) * 2 + (h)) * HTB)
#define PG8_STAGE(bufoff, gbase, voff) do { _Pragma("unroll") for (int _i = 0; _i < 2; ++_i) \
        __builtin_amdgcn_global_load_lds((const unsigned*)((const char*)(gbase) + (voff)[_i]), (PG8_LAS unsigned*)(lds + (bufoff) + ldsw + _i * 8192), 16, 0, 0); } while (0)
#define PG8_LDA(dst, b, h) do { _Pragma("unroll") for (int m = 0; m < 4; ++m) _Pragma("unroll") for (int k = 0; k < 2; ++k) dst[m][k] = *(const PG8_LAS bf16x8*)(lds + PG8_SA(b, h) + aoff + m * 2048 + k * 1024); } while (0)
#define PG8_LDB(dst, b, h) do { _Pragma("unroll") for (int n = 0; n < 2; ++n) _Pragma("unroll") for (int k = 0; k < 2; ++k) dst[n][k] = *(const PG8_LAS bf16x8*)(lds + PG8_SB(b, h) + boff + n * 2048 + k * 1024); } while (0)
#define PG8_MMA(ai, bj, At, Bt) do { __builtin_amdgcn_s_setprio(1); _Pragma("unroll") for (int m = 0; m < 4; ++m) _Pragma("unroll") for (int n = 0; n < 2; ++n) _Pragma("unroll") for (int k = 0; k < 2; ++k) \
        acc[ai][bj][m][n] = __builtin_amdgcn_mfma_f32_16x16x32_bf16(Bt[n][k], At[m][k], acc[ai][bj][m][n], 0, 0, 0); __builtin_amdgcn_s_setprio(0); } while (0)
#define PG8_WAIT_V(n) asm volatile("s_waitcnt vmcnt(" #n ")" ::: "memory")
#define PG8_WAIT_L(n) asm volatile("s_waitcnt lgkmcnt(" #n ")" ::: "memory")
#define PG8_BAR __builtin_amdgcn_s_barrier()
#define PG8_SCHED __builtin_amdgcn_sched_barrier(0)
    Unit cur, nxt; int ui = 0;
    if (!S.next(0, cur)) return;
    f32x4 acc[2][2][4][2];
#pragma unroll
    for (int a = 0; a < 2; ++a)
#pragma unroll
        for (int b = 0; b < 2; ++b)
#pragma unroll
            for (int m = 0; m < 4; ++m)
#pragma unroll
                for (int n = 0; n < 2; ++n) acc[a][b][m][n] = (f32x4){0.f, 0.f, 0.f, 0.f};
    bf16x8 At[4][2], B0[2][2], B1[2][2];
    const char* cA = PG8_ABASE(cur); const char* cB = PG8_BBASE(cur);
    S.a_ready(cur);
    if constexpr (SP2) {
        PG8_STAGE(PG8_SB(0, 0), cB, voffB); PG8_STAGE(PG8_SB(0, 1), cB + hstepB, voffB); PG8_STAGE(PG8_SA(0, 0), cA, voffA); PG8_STAGE(PG8_SA(0, 1), cA + hstepA, voffA);
        if (wr == 1) PG8_BAR;
        PG8_WAIT_V(2); PG8_BAR;
        PG8_STAGE(PG8_SB(1, 0), cB + kstep, voffB); PG8_STAGE(PG8_SA(1, 0), cA + kstep, voffA); PG8_STAGE(PG8_SB(1, 1), cB + hstepB + kstep, voffB);
        PG8_WAIT_V(6); PG8_BAR;
    } else {
        PG8_STAGE(PG8_SB(0, 0), cB, voffB); PG8_STAGE(PG8_SA(0, 0), cA, voffA); PG8_STAGE(PG8_SB(0, 1), cB + hstepB, voffB); PG8_STAGE(PG8_SA(0, 1), cA + hstepA, voffA);
        if (wr == 1) PG8_BAR;
        PG8_WAIT_V(4); PG8_BAR;
        PG8_STAGE(PG8_SB(1, 0), cB + kstep, voffB); PG8_STAGE(PG8_SA(1, 0), cA + kstep, voffA); PG8_STAGE(PG8_SB(1, 1), cB + hstepB + kstep, voffB);
        PG8_WAIT_V(6); PG8_BAR;
    }
    for (;;) {
        const bool has_next = S.next(ui + 1, nxt);
        const char* nA = has_next ? PG8_ABASE(nxt) : cA; const char* nB = has_next ? PG8_BBASE(nxt) : cB;
        for (int t = 0; t < nt; t += 2) {
            const bool last = (t == nt - 2);
            const char* a1 = cA + (size_t)(t + 1) * kstep;
            const char* a2 = last ? nA : cA + (size_t)(t + 2) * kstep; const char* b2 = last ? nB : cB + (size_t)(t + 2) * kstep;
            const char* a3 = a2 + kstep; const char* b3 = b2 + kstep;
            if (last && has_next) S.a_ready(nxt);
            if constexpr (SP2) {
            PG8_LDB(B0, 0, 0); PG8_LDB(B1, 0, 1); PG8_SCHED; PG8_LDA(At, 0, 0); PG8_STAGE(PG8_SA(1, 1), a1 + hstepA, voffA);
            PG8_WAIT_V(8); PG8_WAIT_L(0); PG8_BAR; PG8_MMA(0, 0, At, B0); PG8_MMA(0, 1, At, B1); PG8_BAR; PG8_SCHED;
            PG8_LDA(At, 0, 1); PG8_STAGE(PG8_SB(0, 0), b2, voffB); PG8_STAGE(PG8_SB(0, 1), b2 + hstepB, voffB); PG8_STAGE(PG8_SA(0, 0), a2, voffA);
            PG8_WAIT_V(8); PG8_WAIT_L(0); PG8_BAR; PG8_MMA(1, 0, At, B0); PG8_MMA(1, 1, At, B1); PG8_BAR; PG8_SCHED;
            PG8_LDB(B0, 1, 0); PG8_LDB(B1, 1, 1); PG8_SCHED; PG8_LDA(At, 1, 0); PG8_STAGE(PG8_SA(0, 1), a2 + hstepA, voffA);
            PG8_WAIT_V(8); PG8_WAIT_L(0); PG8_BAR; PG8_MMA(0, 0, At, B0); PG8_MMA(0, 1, At, B1); PG8_BAR; PG8_SCHED;
            PG8_LDA(At, 1, 1); PG8_STAGE(PG8_SB(1, 0), b3, voffB); PG8_STAGE(PG8_SB(1, 1), b3 + hstepB, voffB); PG8_STAGE(PG8_SA(1, 0), a3, voffA);
            PG8_WAIT_V(8); PG8_WAIT_L(0); PG8_BAR; PG8_MMA(1, 0, At, B0); PG8_MMA(1, 1, At, B1); PG8_BAR; PG8_SCHED;
            } else {
            PG8_LDB(B0, 0, 0); PG8_SCHED; PG8_LDA(At, 0, 0); PG8_STAGE(PG8_SA(1, 1), a1 + hstepA, voffA);
            PG8_WAIT_L(8); PG8_BAR; PG8_WAIT_L(0); PG8_MMA(0, 0, At, B0); PG8_BAR; PG8_SCHED;
            PG8_LDB(B1, 0, 1); PG8_STAGE(PG8_SB(0, 0), b2, voffB);
            PG8_BAR; PG8_WAIT_L(0); PG8_MMA(0, 1, At, B1); PG8_BAR;
            PG8_LDA(At, 0, 1); PG8_STAGE(PG8_SA(0, 0), a2, voffA);
            PG8_BAR; PG8_WAIT_L(0); PG8_MMA(1, 0, At, B0); PG8_BAR; PG8_SCHED;
            PG8_STAGE(PG8_SB(0, 1), b2 + hstepB, voffB);
            PG8_WAIT_V(6); PG8_BAR; PG8_MMA(1, 1, At, B1); PG8_BAR;
            PG8_LDB(B0, 1, 0); PG8_SCHED; PG8_LDA(At, 1, 0); PG8_STAGE(PG8_SA(0, 1), a2 + hstepA, voffA);
            PG8_WAIT_L(8); PG8_BAR; PG8_WAIT_L(0); PG8_MMA(0, 0, At, B0); PG8_BAR; PG8_SCHED;
            PG8_LDB(B1, 1, 1); PG8_STAGE(PG8_SB(1, 0), b3, voffB);
            PG8_BAR; PG8_WAIT_L(0); PG8_MMA(0, 1, At, B1); PG8_BAR;
            PG8_LDA(At, 1, 1); PG8_STAGE(PG8_SA(1, 0), a3, voffA);
            PG8_BAR; PG8_WAIT_L(0); PG8_MMA(1, 0, At, B0); PG8_BAR; PG8_SCHED;
            PG8_STAGE(PG8_SB(1, 1), b3 + hstepB, voffB);
            PG8_WAIT_V(6); PG8_BAR; PG8_MMA(1, 1, At, B1); PG8_BAR;
            }
        }
        if constexpr (ALIGN_EPI) { if (wr == 0) PG8_BAR; }
        if constexpr (!Epi::AFTER_DRAIN) { E(acc, cur, wr, wc, fr, fq); S.done(cur); }
        if (!has_next) break;
#pragma unroll
        for (int a = 0; a < 2; ++a)
#pragma unroll
            for (int b = 0; b < 2; ++b)
#pragma unroll
                for (int m = 0; m < 4; ++m)
#pragma unroll
                    for (int n = 0; n < 2; ++n) acc[a][b][m][n] = (f32x4){0.f, 0.f, 0.f, 0.f};
        cur = nxt; cA = nA; cB = nB; ++ui;
        if constexpr (ALIGN_EPI) { if (wr == 1) PG8_BAR; }
    }
    PG8_WAIT_V(0);
    if constexpr (!ALIGN_EPI) { if (wr == 0) PG8_BAR; }
    PG8_BAR;
    if constexpr (Epi::AFTER_DRAIN) { E.fused(acc, cur, wr, wc, fr, fq, lds, wid, lane); S.done(cur); }
#undef PG8_ABASE
#undef PG8_BBASE
#undef PG8_SA
#undef PG8_SB
#undef PG8_STAGE
#undef PG8_LDA
#undef PG8_LDB
#undef PG8_MMA
#undef PG8_WAIT_V
#undef PG8_WAIT_L
#undef PG8_BAR
#undef PG8_SCHED
}
}

namespace att {
constexpr int ZP = N1;
constexpr int STAGE = 35840, LSM_OFF = 3 * STAGE, XB_STRIDE = 129;
__device__ __forceinline__ int crow(int r, int hi) { return (r & 3) + 8 * (r >> 2) + 4 * hi; }

struct UnitArgs {
    const bf16* zq;
    const bf16* vt_lat; const bf16* vt_ctx;
    const float* qgain;
    bf16* yo;
    int qrow0;
    int tq0;
    int krow_lat;
    int krow_ctx;
    int kcol;
    int qcol0;
    int ycol0;
    int kt0, nlat;
    float M2;
    float sinkl2;
    const float* sink;
    int hq0;
    float lam, oscale;
    const float* subln;
};

template <int MODE>
__device__ __forceinline__ void attn_unit(LAS unsigned char* lds, const int tid_in, const UnitArgs& A) {
    int tid = tid_in; asm volatile("" : "+v"(tid));
    constexpr int KROWB = MODE == 0 ? 272 : 144;
    constexpr int VRS = 144;
    constexpr int KSZ = 64 * KROWB;
    constexpr int NDT = MODE == 0 ? 4 : 2;
    constexpr int NLD = MODE == 0 ? 2 : 1;
    constexpr int KCH = MODE == 0 ? 16 : 8;
    const int lane = tid & 63, r32 = lane & 31, hh = lane >> 5;
    const int w = __builtin_amdgcn_readfirstlane(tid >> 6);
    const int wrow = MODE == 0 ? 32 * (w & 3) : 32 * (w & 1);
    const int half = MODE == 0 ? (w >> 2) : 0;
    const int qcol = MODE == 0 ? A.qcol0 + half * 64 : A.qcol0 + (w >> 1) * 64;
    const int khalf = MODE == 0 ? half * 128 : 0;
    const bool lat = A.tq0 >= 0;

    bf16x8 qf[4];
    {
        const bf16* qp = A.zq + (size_t)(A.qrow0 + wrow + r32) * ZP + qcol + 8 * hh;
        float y[4][8]; float ss = 0.f;
#pragma unroll
        for (int ks = 0; ks < 4; ++ks) { const v4u raw = *(const v4u*)(qp + 16 * ks);
            y[ks][0] = bf_lo(raw.x); y[ks][1] = bf_hi(raw.x); y[ks][2] = bf_lo(raw.y); y[ks][3] = bf_hi(raw.y);
            y[ks][4] = bf_lo(raw.z); y[ks][5] = bf_hi(raw.z); y[ks][6] = bf_lo(raw.w); y[ks][7] = bf_hi(raw.w);
#pragma unroll
            for (int j = 0; j < 8; ++j) ss += y[ks][j] * y[ks][j]; }
        ss = xsum32(ss);
        const float rstd = rsqrtf(ss * (1.0f / 64.0f) + EPS);
#pragma unroll
        for (int ks = 0; ks < 4; ++ks)
#pragma unroll
            for (int j = 0; j < 8; ++j) y[ks][j] *= rstd * A.qgain[16 * ks + 8 * hh + j];
        if (lat) {
            const int t = A.tq0 + wrow + r32; const float prow = (float)(t >> 6), pcol = (float)(t & 63);
#pragma unroll
            for (int j = 0; j < 8; ++j) { const float inv = exp2f(-(float)(8 * hh + j) * (13.287712379549449f / 16.0f));
                const float ar = prow * inv, ac = pcol * inv; const float cr = __cosf(ar), sr = __sinf(ar), cc = __cosf(ac), sc = __sinf(ac);
                const float a1 = y[0][j], a2 = y[2][j]; y[0][j] = a1 * cr - a2 * sr; y[2][j] = a2 * cr + a1 * sr;
                const float b1 = y[1][j], b2 = y[3][j]; y[1][j] = b1 * cc - b2 * sc; y[3][j] = b2 * cc + b1 * sc; }
        }
#pragma unroll
        for (int ks = 0; ks < 4; ++ks) { v4u pk; pk.x = cvt_pk_bf16(y[ks][0] * QSCALE, y[ks][1] * QSCALE); pk.y = cvt_pk_bf16(y[ks][2] * QSCALE, y[ks][3] * QSCALE);
            pk.z = cvt_pk_bf16(y[ks][4] * QSCALE, y[ks][5] * QSCALE); pk.w = cvt_pk_bf16(y[ks][6] * QSCALE, y[ks][7] * QSCALE); qf[ks] = __builtin_bit_cast(bf16x8, pk); }
    }
    const int tq = lat ? A.tq0 + wrow + r32 : 0;

    f32x16 o[NDT];
#pragma unroll
    for (int dt = 0; dt < NDT; ++dt)
#pragma unroll
        for (int r = 0; r < 16; ++r) o[dt][r] = 0.f;
    const f32x16 zero16 = {0.f, 0.f, 0.f, 0.f, 0.f, 0.f, 0.f, 0.f, 0.f, 0.f, 0.f, 0.f, 0.f, 0.f, 0.f, 0.f};
    float lsum = 0.f;

    const int nt = (lat ? A.nlat : 0) + 4;
    v4u kreg[NLD], vreg[NLD];
#define ATT_SRC(ii) const int i_ = (ii); const bool loc = lat && i_ < A.nlat; const int j_ = loc ? (A.kt0 + i_) : (i_ - (lat ? A.nlat : 0));
#define ATT_LOAD_K(ii) do { ATT_SRC(ii) \
        const bf16* kb = A.zq + (size_t)((loc ? A.krow_lat : A.krow_ctx) + 64 * j_) * ZP + A.kcol; \
        _Pragma("unroll") for (int n = 0; n < NLD; ++n) { const int c = tid + 512 * n; kreg[n] = *(const v4u*)(kb + (size_t)(c / KCH) * ZP + (c % KCH) * 8); } } while (0)
#define ATT_LOAD_V(ii) do { ATT_SRC(ii) \
        const bf16* vb = (loc ? A.vt_lat : A.vt_ctx) + 64 * j_; const int vpt = loc ? T : CT; \
        _Pragma("unroll") for (int n = 0; n < NLD; ++n) { const int c = tid + 512 * n; vreg[n] = *(const v4u*)(vb + (size_t)(c >> 3) * vpt + (c & 7) * 8); } } while (0)
#define ATT_WRITE_K(st) do { LAS unsigned char* Kw = lds + (st) * STAGE; \
        _Pragma("unroll") for (int n = 0; n < NLD; ++n) { const int c = tid + 512 * n; *(LAS v4u*)(Kw + (c / KCH) * KROWB + (c % KCH) * 16) = kreg[n]; } } while (0)
#define ATT_WRITE_V(st) do { LAS unsigned char* Vw = lds + (st) * STAGE + KSZ; \
        _Pragma("unroll") for (int n = 0; n < NLD; ++n) { const int c = tid + 512 * n; { LAS v2u* vw_ = (LAS v2u*)(Vw + (c >> 3) * VRS + ((c & 7) >> 1) * 32 + (c & 1) * 8); v2u a_; a_.x = vreg[n].x; a_.y = vreg[n].y; v2u b_; b_.x = vreg[n].z; b_.y = vreg[n].w; vw_[0] = a_; vw_[2] = b_; }     } } while (0)
#define ATT_LOAD_TILE(ii) do { ATT_LOAD_K(ii); ATT_LOAD_V(ii); } while (0)
#define ATT_WRITE_TILE(st) do { ATT_WRITE_K(st); ATT_WRITE_V(st); } while (0)

#define ATT_EXP8(P, base, koff) do { _Pragma("unroll") for (int r = (base); r < (base) + 8; ++r) { float e_ = __builtin_amdgcn_exp2f(P[r]); \
        if (MODE == 1) { if (msk) { const int dlt = kv0m + (koff) + (r & 3) + 8 * (r >> 2); if (dlt > 128 || dlt < -128) e_ = 0.f; } } \
        P[r] = e_; lsum += e_; } } while (0)
#define ATT_VFRAG(dst, dt_, s__) do { dst = *(const LAS bf16x8*)(vp + (dt_) * 32 * VRS + 32 * (s__)); } while (0)
#define ATT_STEP(C0, C1, N0, N1, ii, PRE) do { const int i_s = (ii); const bool more = (PRE) || (i_s + 2 < nt); const bool more3 = (PRE) || (i_s + 3 < nt); \
        const LAS unsigned char* kpn = lds + st_nxt * STAGE + r32 * KROWB + khalf + 16 * hh; \
        const LAS unsigned char* vp = lds + st_cur * STAGE + KSZ + r32 * VRS + 16 * hh; \
        const bool msk = (MODE == 1) && lat && (i_s < A.nlat); const int kv0m = 64 * (A.kt0 + i_s) + 4 * hh - tq; \
        { const bf16x8 a0 = *(const LAS bf16x8*)(kpn); const bf16x8 a1 = *(const LAS bf16x8*)(kpn + 32 * KROWB); \
          N0 = __builtin_amdgcn_mfma_f32_32x32x16_bf16(a0, qf[0], zero16, 0, 0, 0); N1 = __builtin_amdgcn_mfma_f32_32x32x16_bf16(a1, qf[0], zero16, 0, 0, 0); } \
        ATT_EXP8(C0, 0, 0); \
        { const bf16x8 a0 = *(const LAS bf16x8*)(kpn + 32); const bf16x8 a1 = *(const LAS bf16x8*)(kpn + 32 * KROWB + 32); \
          N0 = __builtin_amdgcn_mfma_f32_32x32x16_bf16(a0, qf[1], N0, 0, 0, 0); N1 = __builtin_amdgcn_mfma_f32_32x32x16_bf16(a1, qf[1], N1, 0, 0, 0); } \
        ATT_EXP8(C0, 8, 0); \
        { const bf16x8 a0 = *(const LAS bf16x8*)(kpn + 64); const bf16x8 a1 = *(const LAS bf16x8*)(kpn + 32 * KROWB + 64); \
          N0 = __builtin_amdgcn_mfma_f32_32x32x16_bf16(a0, qf[2], N0, 0, 0, 0); N1 = __builtin_amdgcn_mfma_f32_32x32x16_bf16(a1, qf[2], N1, 0, 0, 0); } \
        ATT_EXP8(C1, 0, 32); \
        { const bf16x8 a0 = *(const LAS bf16x8*)(kpn + 96); const bf16x8 a1 = *(const LAS bf16x8*)(kpn + 32 * KROWB + 96); \
          N0 = __builtin_amdgcn_mfma_f32_32x32x16_bf16(a0, qf[3], N0, 0, 0, 0); N1 = __builtin_amdgcn_mfma_f32_32x32x16_bf16(a1, qf[3], N1, 0, 0, 0); } \
        ATT_EXP8(C1, 8, 32); \
        if (more) { ATT_WRITE_K(st_wr); } if (more3) { ATT_LOAD_K(i_s + 3); } \
        bf16x8 vf[2][NDT]; \
        _Pragma("unroll") for (int dt = 0; dt < NDT; ++dt) { ATT_VFRAG(vf[0][dt], dt, 0); } \
        bf16x8 pa[4]; \
        { v4u t0, t1, t2, t3; \
          t0.x = cvt_pk_bf16(C0[0], C0[1]); t0.y = cvt_pk_bf16(C0[2], C0[3]); t0.z = cvt_pk_bf16(C0[4], C0[5]); t0.w = cvt_pk_bf16(C0[6], C0[7]); \
          t1.x = cvt_pk_bf16(C0[8], C0[9]); t1.y = cvt_pk_bf16(C0[10], C0[11]); t1.z = cvt_pk_bf16(C0[12], C0[13]); t1.w = cvt_pk_bf16(C0[14], C0[15]); \
          t2.x = cvt_pk_bf16(C1[0], C1[1]); t2.y = cvt_pk_bf16(C1[2], C1[3]); t2.z = cvt_pk_bf16(C1[4], C1[5]); t2.w = cvt_pk_bf16(C1[6], C1[7]); \
          t3.x = cvt_pk_bf16(C1[8], C1[9]); t3.y = cvt_pk_bf16(C1[10], C1[11]); t3.z = cvt_pk_bf16(C1[12], C1[13]); t3.w = cvt_pk_bf16(C1[14], C1[15]); \
          pa[0] = __builtin_bit_cast(bf16x8, t0); pa[1] = __builtin_bit_cast(bf16x8, t1); pa[2] = __builtin_bit_cast(bf16x8, t2); pa[3] = __builtin_bit_cast(bf16x8, t3); } \
        _Pragma("unroll") for (int s_ = 0; s_ < 4; ++s_) { \
            if (s_ < 3) { _Pragma("unroll") for (int dt = 0; dt < NDT; ++dt) { ATT_VFRAG(vf[(s_ + 1) & 1][dt], dt, s_ + 1); } } \
            _Pragma("unroll") for (int dt = 0; dt < NDT; ++dt) o[dt] = __builtin_amdgcn_mfma_f32_32x32x16_bf16(pa[s_], vf[s_ & 1][dt], o[dt], 0, 0, 0); } \
        if (more) { ATT_WRITE_V(st_wr); } if (more3) { ATT_LOAD_V(i_s + 3); } \
        __syncthreads(); \
        { const int t_ = st_cur; st_cur = st_nxt; st_nxt = st_wr; st_wr = t_; } } while (0)

    int st_cur = 0, st_nxt = 1, st_wr = 2;
    ATT_LOAD_TILE(0); ATT_WRITE_TILE(0); ATT_LOAD_TILE(1); ATT_WRITE_TILE(1); __syncthreads();
    ATT_LOAD_TILE(2);
    f32x16 cA0, cA1, cB0, cB1;
    {
        const LAS unsigned char* kp = lds + r32 * KROWB + khalf + 16 * hh;
#pragma unroll
        for (int ks = 0; ks < 4; ++ks) {
            const bf16x8 a0 = *(const LAS bf16x8*)(kp + 32 * ks);
            const bf16x8 a1 = *(const LAS bf16x8*)(kp + 32 * KROWB + 32 * ks);
            if (ks == 0) { cA0 = __builtin_amdgcn_mfma_f32_32x32x16_bf16(a0, qf[0], zero16, 0, 0, 0); cA1 = __builtin_amdgcn_mfma_f32_32x32x16_bf16(a1, qf[0], zero16, 0, 0, 0); }
            else { cA0 = __builtin_amdgcn_mfma_f32_32x32x16_bf16(a0, qf[ks], cA0, 0, 0, 0); cA1 = __builtin_amdgcn_mfma_f32_32x32x16_bf16(a1, qf[ks], cA1, 0, 0, 0); }
        }
    }
    int i = 0;
    for (; i + 4 < nt; i += 2) {
        ATT_STEP(cA0, cA1, cB0, cB1, i, true);
        ATT_STEP(cB0, cB1, cA0, cA1, i + 1, true);
    }
    for (; i < nt; i += 2) {
        ATT_STEP(cA0, cA1, cB0, cB1, i, false);
        if (i + 1 < nt) ATT_STEP(cB0, cB1, cA0, cA1, i + 1, false);
    }
#undef ATT_STEP
#undef ATT_VFRAG
#undef ATT_EXP8

    LAS float* lsm = (LAS float*)(lds + LSM_OFF);
    {
    int t3 = tid_in; asm volatile("" : "+v"(t3)); const int r32 = t3 & 31, hh = (t3 >> 5) & 1;
    float lt = xsum32(lsum);
    if (MODE == 1) lt += __builtin_amdgcn_exp2f(A.sink[A.hq0 + (w >> 1)] * LOG2E);
    if (hh == 0) lsm[w * 32 + r32] = lt;
    __syncthreads();
    if (MODE == 1) {
        LAS bf16* ost = (LAS bf16*)lds;
#pragma unroll
        for (int r = 0; r < 16; ++r) { const int q = crow(r, hh); const float f = __builtin_amdgcn_rcpf(lsm[w * 32 + q]);
#pragma unroll
            for (int dt = 0; dt < NDT; ++dt) ost[(wrow + q) * 264 + (w >> 1) * 64 + 32 * dt + r32] = (bf16)(cvt_pk_bf16(o[dt][r] * f, 0.f) & 0xffffu); }
        __syncthreads();
        { const int te = w * 64 + (t3 & 63);
#pragma unroll
          for (int n = 0; n < 4; ++n) { const int c = te + 512 * n, row = c >> 5, ch = c & 31;
              *(v4u*)(A.yo + (size_t)(A.qrow0 + row) * YW + A.ycol0 + ch * 8) = *(const LAS v4u*)((LAS unsigned char*)lds + row * 528 + ch * 16); } }
        __syncthreads();
    } else {
        LAS float* Xb = (LAS float*)lds;
        if (w >= 4) {
#pragma unroll
            for (int r = 0; r < 16; ++r) { const int q = crow(r, hh); const float f = -A.lam * __builtin_amdgcn_rcpf(lsm[w * 32 + q]);
#pragma unroll
                for (int dt = 0; dt < NDT; ++dt) Xb[(wrow + q) * XB_STRIDE + 32 * dt + r32] = o[dt][r] * f; }
        }
        __syncthreads();
        if (w < 4) {
            LAS bf16* ost = (LAS bf16*)(lds + 66560);
            float sl[NDT];
#pragma unroll
            for (int dt = 0; dt < NDT; ++dt) sl[dt] = A.subln[32 * dt + r32] * A.oscale;
#pragma unroll
            for (int r = 0; r < 16; ++r) { const int q = crow(r, hh); const float f = __builtin_amdgcn_rcpf(lsm[w * 32 + q]);
                float v[NDT]; float ss = 0.f;
#pragma unroll
                for (int dt = 0; dt < NDT; ++dt) { v[dt] = o[dt][r] * f + Xb[(wrow + q) * XB_STRIDE + 32 * dt + r32]; ss += v[dt] * v[dt]; }
                ss += swz_xor<1>(ss); ss += swz_xor<2>(ss); ss += swz_xor<4>(ss); ss += swz_xor<8>(ss); ss += swz_xor<16>(ss);
                const float rstd = rsqrtf(ss * (1.0f / 128.0f) + EPS);
#pragma unroll
                for (int dt = 0; dt < NDT; ++dt) ost[(wrow + q) * 136 + 32 * dt + r32] = (bf16)(cvt_pk_bf16(v[dt] * rstd * sl[dt], 0.f) & 0xffffu); }
        }
        __syncthreads();
        { const int te = w * 64 + (t3 & 63);
#pragma unroll
          for (int n = 0; n < 4; ++n) { const int c = te + 512 * n, row = c >> 4, ch = c & 15;
              *(v4u*)(A.yo + (size_t)(A.qrow0 + row) * YW + A.ycol0 + ch * 8) = *(const LAS v4u*)(lds + 66560 + row * 272 + ch * 16); } }
        __syncthreads();
    }
    }
}
#undef ATT_LOAD_TILE
#undef ATT_WRITE_TILE
#undef ATT_LOAD_K
#undef ATT_LOAD_V
#undef ATT_WRITE_K
#undef ATT_WRITE_V
#undef ATT_SRC
}


namespace mg {
constexpr int BK = 32, RS = 80, TILE_B = 256 * RS, STG = 2 * TILE_B;

template <int ACT  > struct EpiStore {
    bf16* O; int ldc;
    __device__ __forceinline__ void operator()(const f32x16 (&acc)[4][2], const pg8::Unit& u, int wm, int wn, int r32, int hh) const {
#pragma unroll
        for (int mi = 0; mi < 4; ++mi) { bf16* rowp = O + (size_t)(u.pm * 256 + wm * 128 + mi * 32 + r32) * ldc + u.pn * 256 + wn * 64 + 4 * hh;
#pragma unroll
            for (int ni = 0; ni < 2; ++ni)
#pragma unroll
                for (int g = 0; g < 4; ++g) { float v[4];
#pragma unroll
                    for (int e = 0; e < 4; ++e) { float x = acc[mi][ni][4 * g + e];
                        if (ACT == 1) x = pg8::act_sigmoid(x);
                        if (ACT == 2) { x = fmaxf(x, 0.f); x = x * x; }
                        v[e] = x; }
                    v2u w; w.x = cvt_pk_bf16(v[0], v[1]); w.y = cvt_pk_bf16(v[2], v[3]);
                    *(v2u*)(rowp + ni * 32 + 8 * g) = w; } }
    }
};
struct EpiGate {
    bf16* G; int ldc;
    __device__ __forceinline__ void operator()(const f32x16 (&acc)[4][2], const pg8::Unit& u, int wm, int wn, int r32, int hh) const {
#pragma unroll
        for (int mi = 0; mi < 4; ++mi) { bf16* rowp = G + (size_t)(u.pm * 256 + wm * 128 + mi * 32 + r32) * ldc + u.pn * 256 + wn * 64 + 4 * hh;
#pragma unroll
            for (int ni = 0; ni < 2; ++ni)
#pragma unroll
                for (int g = 0; g < 4; ++g) { const v2u q = *(const v2u*)(rowp + ni * 32 + 8 * g);
                    v2u w; w.x = cvt_pk_bf16(acc[mi][ni][4 * g] * bf_lo(q.x), acc[mi][ni][4 * g + 1] * bf_hi(q.x)); w.y = cvt_pk_bf16(acc[mi][ni][4 * g + 2] * bf_lo(q.y), acc[mi][ni][4 * g + 3] * bf_hi(q.y));
                    *(v2u*)(rowp + ni * 32 + 8 * g) = w; } }
    }
};
struct EpiResid {
    const float* res_lat; const float* res_ctx; float* out_lat; float* out_ctx; const float* modg;
    __device__ __forceinline__ void operator()(const f32x16 (&acc)[4][2], const pg8::Unit& u, int wm, int wn, int r32, int hh) const {
        const int r0 = u.pm * 256; const bool lat = r0 < MLAT;
        const float* res = lat ? res_lat : res_ctx - (size_t)MLAT * D; float* out = lat ? out_lat : out_ctx - (size_t)MLAT * D;
        const float* mg_ = modg + (size_t)(lat ? (r0 / T) : NB) * 6144 + u.pn * 256 + wn * 64 + 4 * hh;
#pragma unroll
        for (int ni = 0; ni < 2; ++ni)
#pragma unroll
            for (int g = 0; g < 4; ++g) { const f32x4 gv = *(const f32x4*)(mg_ + ni * 32 + 8 * g);
#pragma unroll
                for (int mi = 0; mi < 4; ++mi) { const size_t ro = (size_t)(r0 + wm * 128 + mi * 32 + r32) * D + u.pn * 256 + wn * 64 + 4 * hh + ni * 32 + 8 * g;
                    const f32x4 r = *(const f32x4*)(res + ro);
                    f32x4 a; a.x = acc[mi][ni][4 * g]; a.y = acc[mi][ni][4 * g + 1]; a.z = acc[mi][ni][4 * g + 2]; a.w = acc[mi][ni][4 * g + 3];
                    *(f32x4*)(out + ro) = r + gv * a; } }
    }
};

template <class Epi>
__device__ __forceinline__ void gemm(LAS unsigned char* lds, const int tid, const pg8::Gemm g, const pg8::StaticOrder& S, const Epi& E) {
    const int lane = tid & 63, r32 = lane & 31, hh = lane >> 5;
    const int w = __builtin_amdgcn_readfirstlane(tid >> 6), wm = w >> 2, wn = w & 3;
    const int nk = g.K / BK;
    const int lrow = tid >> 2, lkc = tid & 3;
    pg8::Unit u;
    for (int ui = 0; S.next(ui, u); ++ui) {
        const bf16* Ab = g.A + (size_t)u.pm * 256 * g.lda + (g.agrp ? (size_t)(u.pn / g.agrp) * g.agstride : (size_t)0) + (size_t)lrow * g.lda + lkc * 8;
        const bf16* Bb = g.Bt + (size_t)u.pn * 256 * g.ldb + (size_t)lrow * g.ldb + lkc * 8;
        f32x16 acc[4][2];
#pragma unroll
        for (int mi = 0; mi < 4; ++mi)
#pragma unroll
            for (int ni = 0; ni < 2; ++ni)
#pragma unroll
                for (int r = 0; r < 16; ++r) acc[mi][ni][r] = 0.f;
        v4u ar[2], br[2];
#define MG_LOAD(kt_) do { const int ko = (kt_) * BK; \
        ar[0] = *(const v4u*)(Ab + ko); ar[1] = *(const v4u*)(Ab + (size_t)128 * g.lda + ko); \
        br[0] = *(const v4u*)(Bb + ko); br[1] = *(const v4u*)(Bb + (size_t)128 * g.ldb + ko); } while (0)
#define MG_WRITE(st_) do { LAS unsigned char* Aw = lds + (st_) * STG + lrow * RS + lkc * 16; \
        *(LAS v4u*)(Aw) = ar[0]; *(LAS v4u*)(Aw + 128 * RS) = ar[1]; \
        *(LAS v4u*)(Aw + TILE_B) = br[0]; *(LAS v4u*)(Aw + TILE_B + 128 * RS) = br[1]; } while (0)
        MG_LOAD(0); MG_WRITE(0); __syncthreads();
        for (int kt = 0; kt < nk; ++kt) {
            if (kt + 1 < nk) MG_LOAD(kt + 1);
            const LAS unsigned char* As = lds + (kt & 1) * STG + (wm * 128 + r32) * RS + 16 * hh;
            const LAS unsigned char* Bs = lds + (kt & 1) * STG + TILE_B + (wn * 64 + r32) * RS + 16 * hh;
#pragma unroll
            for (int ks = 0; ks < 2; ++ks) {
                bf16x8 af[4], bq[2];
#pragma unroll
                for (int mi = 0; mi < 4; ++mi) af[mi] = *(const LAS bf16x8*)(As + mi * 32 * RS + 32 * ks);
#pragma unroll
                for (int ni = 0; ni < 2; ++ni) bq[ni] = *(const LAS bf16x8*)(Bs + ni * 32 * RS + 32 * ks);
#pragma unroll
                for (int mi = 0; mi < 4; ++mi)
#pragma unroll
                    for (int ni = 0; ni < 2; ++ni) acc[mi][ni] = __builtin_amdgcn_mfma_f32_32x32x16_bf16(bq[ni], af[mi], acc[mi][ni], 0, 0, 0);
            }
            if (kt + 1 < nk) MG_WRITE((kt + 1) & 1);
            __syncthreads();
        }
#undef MG_LOAD
#undef MG_WRITE
        E(acc, u, wm, wn, r32, hh);
    }
}
}


#define XB_TMO      128
#define XB_XCNT(j)  (256  + 64 * (j))
#define XB_XSUB(j)  (1280 + 64 * (j))
#define XB_XGEN(j)  (2304 + 64 * (j))
#define XB_TOP      3328
#define XB_TOPGEN   3392
#define XCD_BAR_WORDS 3456
#define XB_SPIN_CAP (1u << 18)

__device__ __forceinline__ unsigned xb_ld(unsigned* p)              { return __hip_atomic_load(p, __ATOMIC_RELAXED, __HIP_MEMORY_SCOPE_AGENT); }
__device__ __forceinline__ unsigned xb_add(unsigned* p, unsigned v) { return __hip_atomic_fetch_add(p, v, __ATOMIC_RELAXED, __HIP_MEMORY_SCOPE_AGENT); }
__device__ __forceinline__ unsigned xb_xcc_id() { return (unsigned)__builtin_amdgcn_s_getreg((3 << 11) | 20) & 0xFu; }
#define XB_SPIN(cond, bar) do { unsigned _sp = 0; while (cond) { __builtin_amdgcn_s_sleep(1); \
    if ((++_sp & 255u) == 0u) { if (xb_ld(&(bar)[XB_TMO])) break; if (_sp > XB_SPIN_CAP) { atomicAdd(&(bar)[XB_TMO], 1u); break; } } } } while (0)

struct XcdBarrier {
    unsigned* bar; unsigned x;
    volatile LAS unsigned* st;
};

__device__ __forceinline__ XcdBarrier xcd_barrier_post(unsigned* bar, volatile LAS unsigned* st) {
    XcdBarrier b; b.bar = bar; b.x = xb_xcc_id(); b.st = st;
    if (threadIdx.x == 0) (void)xb_add(&bar[XB_XCNT(b.x)], 1u);
    return b;
}
__device__ __forceinline__ void xcd_barrier_complete(unsigned* bar, unsigned x, unsigned& nloc, unsigned& nx) {
    const unsigned G = gridDim.x * gridDim.y * gridDim.z;
    unsigned sum, cnt, mine, sp = 0u;
    for (;;) {
        sum = 0u; cnt = 0u; mine = 0u;
#pragma unroll
        for (unsigned j = 0; j < 16; ++j) { const unsigned c = xb_ld(&bar[XB_XCNT(j)]); sum += c; cnt += (c > 0u) ? 1u : 0u; mine = (j == x) ? c : mine; }
        if (sum == G) break;
        __builtin_amdgcn_s_sleep(1);
        if ((++sp & 255u) == 0u) { if (xb_ld(&bar[XB_TMO])) break; if (sp > XB_SPIN_CAP) { atomicAdd(&bar[XB_TMO], 1u); break; } }
    }
    nloc = mine > 0u ? mine : 1u; nx = cnt > 0u ? cnt : 1u;
}

__device__ __forceinline__ void xcd_barrier(const XcdBarrier& b, const bool is_t0) {
    asm volatile("s_waitcnt vmcnt(0)" ::: "memory");
    __syncthreads();
    if (is_t0) {
        unsigned* bar = b.bar;
        __builtin_amdgcn_s_waitcnt(0);
        unsigned nloc = b.st[0], nx = b.st[1];
        if (nloc == 0u) { xcd_barrier_complete(bar, b.x, nloc, nx); b.st[0] = nloc; b.st[1] = nx; }
        const unsigned old = xb_add(&bar[XB_XSUB(b.x)], 1u);
        const unsigned gen = old / nloc;
        if (old + 1u == (gen + 1u) * nloc) {
            __builtin_amdgcn_fence(__ATOMIC_RELEASE, "agent");
            asm volatile("s_waitcnt vmcnt(0)" ::: "memory");
            const unsigned og = xb_add(&bar[XB_TOP], 1u);
            const unsigned tg = og / nx;
            if (og + 1u == (tg + 1u) * nx) xb_add(&bar[XB_TOPGEN], 1u);
            else XB_SPIN(xb_ld(&bar[XB_TOPGEN]) == tg, bar);
            __builtin_amdgcn_fence(__ATOMIC_ACQUIRE, "agent");
            xb_add(&bar[XB_XGEN(b.x)], 1u);
            asm volatile("s_waitcnt vmcnt(0)" ::: "memory");
        } else {
            XB_SPIN(xb_ld(&bar[XB_XGEN(b.x)]) == gen, bar);
            __builtin_amdgcn_fence(__ATOMIC_ACQUIRE, "agent");
            asm volatile("s_waitcnt vmcnt(0)" ::: "memory");
        }
    }
    __syncthreads();
}

struct Args {
    const float* in[24]; float* out; unsigned char* ws;
    int ph_lo, ph_hi;
};
struct Frame {
    LAS unsigned char* lds; int tid, lane, wave, G, vcu, gw, NGW, bx;
};

__device__ __forceinline__ void tr_item(const float* W, int ldw, int Nsub, bf16* WT, int ldt, LAS float* scr, int item, int lane) {
    const int nblk = Nsub / 32, kb = item / nblk, nb = item % nblk, k0 = 64 * kb, n0 = 32 * nb;
#pragma unroll 8
    for (int i = 0; i < 32; ++i) { const int kk = 2 * i + (lane >> 5); scr[kk * 33 + (lane & 31)] = __builtin_nontemporal_load(&W[(size_t)(k0 + kk) * ldw + n0 + (lane & 31)]); }
    asm volatile("s_waitcnt lgkmcnt(0)" ::: "memory");
    const int c = lane & 7;
#pragma unroll
    for (int j = 0; j < 4; ++j) { const int n = (lane >> 3) + 8 * j; const LAS float* s = scr + (8 * c) * 33 + n;
        v4u o; o.x = cvt_pk_bf16(s[0 * 33], s[1 * 33]); o.y = cvt_pk_bf16(s[2 * 33], s[3 * 33]); o.z = cvt_pk_bf16(s[4 * 33], s[5 * 33]); o.w = cvt_pk_bf16(s[6 * 33], s[7 * 33]);
        *(v4u*)(WT + (size_t)(n0 + n) * ldt + k0 + 8 * c) = o; }
    asm volatile("s_waitcnt lgkmcnt(0)" ::: "memory");
}

__device__ __forceinline__ void norm_mod_rows(const Frame& F, const float* xlat, const float* xctx, const float* gain, const float* modl, int ch_shift, int ch_scale, bf16* XN) {
#pragma unroll 2
    for (int r = F.gw; r < MTOT; r += F.NGW) {
        const bool lat = r < MLAT; const float* xrow = lat ? xlat + (size_t)r * D : xctx + (size_t)(r - MLAT) * D;
        const float* mb = modl + (size_t)(lat ? r / T : NB) * 6144;
        const f32x4* xr = (const f32x4*)xrow + F.lane;
        f32x4 v[4]; float s = 0.f;
#pragma unroll
        for (int j = 0; j < 4; ++j) { v[j] = xr[64 * j]; s += (v[j].x * v[j].x + v[j].y * v[j].y) + (v[j].z * v[j].z + v[j].w * v[j].w); }
        const float rstd = rsqrtf(wave_sum(s) * (1.f / D) + EPS);
        v2u* o8 = (v2u*)(XN + (size_t)r * D) + F.lane;
#pragma unroll
        for (int j = 0; j < 4; ++j) { const int c = 4 * F.lane + 256 * j;
            const f32x4 g = *(const f32x4*)(gain + c), sh = *(const f32x4*)(mb + ch_shift * 1024 + c), sc = *(const f32x4*)(mb + ch_scale * 1024 + c);
            const f32x4 y = v[j] * rstd * g * (sc + 1.0f) + sh;
            v2u pk; pk.x = cvt_pk_bf16(y.x, y.y); pk.y = cvt_pk_bf16(y.z, y.w); o8[64 * j] = pk; }
    }
}


template <int KIND>
__device__ __forceinline__ void simple_gemm(const Frame& F, const bf16* A, int lda, int agrp_cols, int agstride, const bf16* Bt, int ldb, int M, int N, int K,
                                            bf16* O, int ldc, const float* res_lat_, const float* res_ctx_, float* out_lat_, float* out_ctx_, const float* modg) {
    const int r32 = F.lane & 31, hh = F.lane >> 5; const int ntn = N / 32, ntiles = (M / 32) * ntn;
    for (int tt = F.gw; tt < ntiles; tt += F.NGW) {
        const int tm = tt / ntn, tn = tt % ntn;
        const int aoff = agrp_cols ? ((tn * 32) / agrp_cols) * agstride : 0;
        const bf16* ap = A + (size_t)(tm * 32 + r32) * lda + aoff + 8 * hh;
        const bf16* bp = Bt + (size_t)(tn * 32 + r32) * ldb + 8 * hh;
        f32x16 acc;
#pragma unroll
        for (int r = 0; r < 16; ++r) acc[r] = 0.f;
        for (int k0 = 0; k0 < K; k0 += 16) {
            const bf16x8 a = *(const bf16x8*)(ap + k0), b = *(const bf16x8*)(bp + k0);
            acc = __builtin_amdgcn_mfma_f32_32x32x16_bf16(a, b, acc, 0, 0, 0);
        }
        const int col = tn * 32 + r32;
#pragma unroll
        for (int r = 0; r < 16; ++r) { const int row = tm * 32 + (r & 3) + 8 * (r >> 2) + 4 * hh; float v = acc[r];
            if (KIND == 1) v = pg8::act_sigmoid(v);
            if (KIND == 2) { v = fmaxf(v, 0.f); v = v * v; }
            if (KIND <= 2) O[(size_t)row * ldc + col] = (bf16)(cvt_pk_bf16(v, 0.f) & 0xffffu);
            if (KIND == 3) { bf16* gp = O + (size_t)row * ldc + col; *gp = (bf16)(cvt_pk_bf16(v * bf1(*gp), 0.f) & 0xffffu); }
            if (KIND == 4) { const bool lat = row < MLAT; const int bidx = lat ? row / T : NB;
                const float* rp = lat ? res_lat_ + (size_t)row * D : res_ctx_ + (size_t)(row - MLAT) * D; float* op = lat ? out_lat_ + (size_t)row * D : out_ctx_ + (size_t)(row - MLAT) * D;
                op[col] = rp[col] + modg[(size_t)bidx * 6144 + col] * v; } }
    }
}

__global__ void __launch_bounds__(NWAVES * 64, 2) fwd_mega(Args args) {
    extern __shared__ __attribute__((aligned(16))) unsigned char lds_raw[];
    cg::grid_group grid = cg::this_grid();
    Frame F;
    F.lds = (LAS unsigned char*)lds_raw;
    F.tid = threadIdx.x; F.lane = F.tid & 63; F.wave = __builtin_amdgcn_readfirstlane(F.tid >> 6);
    const int wave_s = __builtin_amdgcn_readfirstlane((int)threadIdx.x >> 6);
    F.G = gridDim.x; { const int bx = blockIdx.x; F.vcu = (F.G % 8 == 0) ? (bx % 8) * (F.G / 8) + bx / 8 : bx; }
    F.gw = blockIdx.x * NWAVES + F.wave; F.NGW = F.G * NWAVES;
    volatile LAS unsigned* xb_st = (volatile LAS unsigned*)(F.lds + 132096);
    if (threadIdx.x == 0) { xb_st[0] = 0u; xb_st[1] = 0u; }
    __syncthreads();
    XcdBarrier bar = xcd_barrier_post((unsigned*)(args.ws + WS_CTL) + 4096, xb_st);
    if (args.ph_hi < 0) grid.sync();
#define AS4 __attribute__((address_space(4)))
#define INP(i) (*(const float* const AS4*)(kp + 8 * (i)))
#define ws (*(unsigned char* const AS4*)(kp + 200))
#define out (*(float* const AS4*)(kp + 192))
#define x_in INP(0)
#define c_in INP(1)
#define ctx_in INP(2)
#define cctx_in INP(3)
#define w_ada INP(4)
#define b_ada INP(5)
#define norm1 INP(6)
#define norm2 INP(7)
#define w_in INP(8)
#define w_pool INP(9)
#define pool_scale INP(10)
#define swa_qn INP(11)
#define swa_kn INP(12)
#define swa_sink INP(13)
#define diff_qn INP(14)
#define diff_kn INP(15)
#define diff_lambda INP(16)
#define diff_subln INP(17)
#define w_br_pool INP(18)
#define w_br_swa INP(19)
#define w_br_diff INP(20)
#define w_out INP(21)
#define w_ff1 INP(22)
#define w_ff2 INP(23)
#define mod ((float*)(ws + WS_MOD))
#define lamv ((float*)(ws + WS_LAM))
#define XC ((float*)(ws + WS_XC))
#define XN ((bf16*)(ws + WS_XN))
#define Y ((bf16*)(ws + WS_Y))
#define Z1 ((bf16*)(ws + WS_BIG + BO_Z1))
#define VT ((bf16*)(ws + WS_BIG + BO_VT))
#define GB ((bf16*)(ws + WS_BIG + BO_G))
#define MG ((bf16*)(ws + WS_BIG + BO_MG))
#define HB ((bf16*)(ws + WS_BIG + BO_H))
#define wl (ws + WS_W + (size_t)l * WL_STRIDE)
#define modl (mod + (size_t)l * 5 * 6144)
#define res_lat (l == 0 ? x_in : (const float*)out)
#define res_ctx (l == 0 ? ctx_in : (const float*)XC)
    int ph = 0;
    const int lo = args.ph_lo, hi = args.ph_hi;
#define PH_BEGIN if (lo <= ph && ph < hi) { const AS4 char* kp = (const AS4 char*)__builtin_amdgcn_kernarg_segment_ptr(); asm volatile("" : "+s"(kp)); \
    { int tid_ = wave_s * 64 + (int)__builtin_amdgcn_mbcnt_hi(~0u, __builtin_amdgcn_mbcnt_lo(~0u, 0u)); asm volatile("" : "+v"(tid_)); F.tid = tid_; F.lane = tid_ & 63; F.wave = __builtin_amdgcn_readfirstlane(tid_ >> 6); int bx_ = blockIdx.x; asm volatile("" : "+s"(bx_)); int G_ = gridDim.x; asm volatile("" : "+s"(G_)); F.bx = bx_; F.G = G_; F.vcu = (G_ % 8 == 0) ? (bx_ % 8) * (G_ / 8) + bx_ / 8 : bx_; F.gw = bx_ * NWAVES + F.wave; F.NGW = G_ * NWAVES; }
#define PH_END(dosync) if ((dosync) && ph + 1 < hi) { xcd_barrier(bar, F.tid == 0); } } ++ph;

    PH_BEGIN
    {
        LAS float* sc = (LAS float*)F.lds;
        LAS float* part = sc + 5 * 1024;
        if (F.bx < 192) {
            for (int i = F.tid; i < 5 * 1024; i += 512) { const int v = i >> 10, k = i & 1023; const float cv = v < NB ? c_in[v * D + k] : cctx_in[k]; sc[i] = cv / (1.0f + __expf(-cv)); }
            __syncthreads();
            for (int it = F.bx; it < 192; it += F.G) {
                const int l = it / 96, n = (it % 96) * 64 + F.lane;
                const float* wp = w_ada + (size_t)l * D * 6144 + (size_t)(F.wave * 128) * 6144 + n;
                float a0 = 0.f, a1 = 0.f, a2 = 0.f, a3 = 0.f, a4 = 0.f;
#pragma unroll 8
                for (int k = 0; k < 128; ++k) { const float wv = __builtin_nontemporal_load(&wp[(size_t)k * 6144]); const int kk = F.wave * 128 + k;
                    a0 += sc[kk] * wv; a1 += sc[1024 + kk] * wv; a2 += sc[2048 + kk] * wv; a3 += sc[3072 + kk] * wv; a4 += sc[4096 + kk] * wv; }
                part[(F.wave * 5 + 0) * 64 + F.lane] = a0; part[(F.wave * 5 + 1) * 64 + F.lane] = a1; part[(F.wave * 5 + 2) * 64 + F.lane] = a2;
                part[(F.wave * 5 + 3) * 64 + F.lane] = a3; part[(F.wave * 5 + 4) * 64 + F.lane] = a4;
                __syncthreads();
                if (F.tid < 320) { const int v = F.tid >> 6, ln = F.tid & 63; float s = 0.f;
#pragma unroll
                    for (int wv = 0; wv < 8; ++wv) s += part[(wv * 5 + v) * 64 + ln];
                    const int nn = (it % 96) * 64 + ln; mod[((size_t)l * 5 + v) * 6144 + nn] = s + b_ada[(size_t)l * 6144 + nn]; }
                __syncthreads();
            }
        }
        __syncthreads();
        if (F.gw == F.NGW - 1) {
            for (int l = 0; l < NL; ++l) { const float* dl = diff_lambda + (size_t)l * 256;
                const float s1 = wave_sum(dl[F.lane] * dl[64 + F.lane]), s2 = wave_sum(dl[128 + F.lane] * dl[192 + F.lane]);
                const float lam_init = 0.8f - 0.6f * expf(-0.3f * (float)l);
                if (F.lane == 0) lamv[l] = expf(s1) - expf(s2) + lam_init;
                float gq = fabsf(diff_qn[l * 64 + F.lane]), gk = fabsf(diff_kn[l * 64 + F.lane]), sq = fabsf(swa_qn[l * 64 + F.lane]), sk = fabsf(swa_kn[l * 64 + F.lane]);
                gq = wave_max(gq); gk = wave_max(gk); sq = wave_max(sq); sk = wave_max(sk);
                if (F.lane == 0) { lamv[8 + 2 * l] = 64.0f * QSCALE * gq * gk * 1.01f + 0.25f; lamv[8 + 2 * l + 1] = 64.0f * QSCALE * sq * sk * 1.01f + 0.25f; } }
        }
        LAS float* scr = (LAS float*)(F.lds + 32768 + F.wave * 8704);
        constexpr int I_IN1 = 16 * (N1 / 32), I_G = 16 * (NG / 32), I_BR = 8 * 32, I_OUT = 16 * 32, I_1 = 16 * (FF / 32), I_2 = 64 * 32;
        constexpr int I_LAYER = I_IN1 + I_G + 2 * I_BR + I_OUT + I_1 + I_2;
        for (int it = F.gw; it < NL * I_LAYER; it += F.NGW) {
            const int l = it / I_LAYER; int r = it % I_LAYER;
            if (r < I_IN1) { tr_item(w_in + (size_t)l * D * DIN, DIN, N1, (bf16*)(wl + WO_IN1), D, scr, r, F.lane); continue; } r -= I_IN1;
            if (r < I_G) { tr_item(w_in + (size_t)l * D * DIN + N1, DIN, NG, (bf16*)(wl + WO_G), D, scr, r, F.lane); continue; } r -= I_G;
            if (r < I_BR) { tr_item(w_br_swa + (size_t)l * 512 * D, D, D, (bf16*)(wl + WO_BR) + (size_t)1024 * 512, 512, scr, r, F.lane); continue; } r -= I_BR;
            if (r < I_BR) { tr_item(w_br_diff + (size_t)l * 512 * D, D, D, (bf16*)(wl + WO_BR) + (size_t)2048 * 512, 512, scr, r, F.lane); continue; } r -= I_BR;
            if (r < I_OUT) { tr_item(w_out + (size_t)l * D * D, D, D, (bf16*)(wl + WO_OUT), D, scr, r, F.lane); continue; } r -= I_OUT;
            if (r < I_1) { tr_item(w_ff1 + (size_t)l * D * FF, FF, FF, (bf16*)(wl + WO_1), D, scr, r, F.lane); continue; } r -= I_1;
            tr_item(w_ff2 + (size_t)l * FF * D, D, D, (bf16*)(wl + WO_2), FF, scr, r, F.lane);
        }
        for (int it = F.gw; it < NL * 512; it += F.NGW) {
            const int l = it / 512, k = it % 512, g = k >> 7, i = k & 127;
            const float* wp = w_pool + ((size_t)(l * 4 + g) * 128 + i) * 128; const float* ps = pool_scale + (size_t)l * 512 + g * 128;
            const float* wb = w_br_pool + (size_t)l * 512 * D + (size_t)(g * 128) * D + F.lane;
            float acc[16];
#pragma unroll
            for (int p = 0; p < 16; ++p) acc[p] = 0.f;
            for (int j = 0; j < 128; ++j) { const float a = wp[j] * ps[j];
#pragma unroll
                for (int p = 0; p < 16; ++p) acc[p] += a * wb[(size_t)j * D + p * 64]; }
            bf16* wt = (bf16*)(ws + WS_W + (size_t)l * WL_STRIDE + WO_BR);
#pragma unroll
            for (int p = 0; p < 16; ++p) wt[(size_t)(p * 64 + F.lane) * 512 + k] = (bf16)(cvt_pk_bf16(acc[p], 0.f) & 0xffffu);
        }
    }
    PH_END(true)

    PH_BEGIN
    norm_mod_rows(F, x_in, ctx_in, norm1, mod, 0, 1, XN);
    PH_END(true)

    for (int l = 0; l < NL; ++l) {
        const int MEFF = (l + 1 < NL) ? MTOT : MLAT;

        PH_BEGIN
#ifdef SG_P1
        simple_gemm<0>(F, XN, D, 0, 0, (const bf16*)(wl + WO_IN1), D, MTOT, N1, D, Z1, N1, nullptr, nullptr, nullptr, nullptr, nullptr);
#else
        { pg8::Gemm g{XN, (const bf16*)(wl + WO_IN1), MTOT, N1, D, D, D, 0, 0}; pg8::StaticOrder S; S.init(MTOT, N1, F.G, F.bx);
          pg8::EpiStore<0> E{Z1, N1};
          pg8::gemm_phase<pg8::EpiStore<0>, pg8::StaticOrder, true, true>(F.lds, F.tid, g, S, E); }
#endif
        PH_END(true)

        PH_BEGIN
        {
            const float* kn_s = swa_kn + l * 64; const float* kn_d = diff_kn + l * 64;
            {
                const int sub = F.lane >> 3, c = F.lane & 7;
                float inv8[8];
#pragma unroll
                for (int j = 0; j < 8; ++j) inv8[j] = exp2f(-(float)(8 * (c & 1) + j) * (13.287712379549449f / 16.0f));
                for (int q0 = 8 * F.gw; q0 < MTOT * 10; q0 += 8 * F.NGW) {
                    const int q = q0 + sub, r = q / 10, hd = q - r * 10;
                    const bool lat = r < MLAT;
                    const int col = (hd < 2 ? C_KS + hd * 64 : C_KD + (hd - 2) * 64) + 8 * c;
                    const float* gp = (hd < 2 ? kn_s : kn_d) + 8 * c;
                    bf16* zp = Z1 + (size_t)r * N1 + col;
                    const v4u raw = *(const v4u*)zp;
                    float y[8];
                    y[0] = bf_lo(raw.x); y[1] = bf_hi(raw.x); y[2] = bf_lo(raw.y); y[3] = bf_hi(raw.y); y[4] = bf_lo(raw.z); y[5] = bf_hi(raw.z); y[6] = bf_lo(raw.w); y[7] = bf_hi(raw.w);
                    float ss = 0.f;
#pragma unroll
                    for (int j = 0; j < 8; ++j) ss += y[j] * y[j];
                    ss += swz_xor<1>(ss); ss += swz_xor<2>(ss); ss += swz_xor<4>(ss);
                    const float rstd = rsqrtf(ss * (1.f / 64.f) + EPS);
                    const f32x4 g0 = *(const f32x4*)gp, g1 = *(const f32x4*)(gp + 4);
                    y[0] *= rstd * g0.x; y[1] *= rstd * g0.y; y[2] *= rstd * g0.z; y[3] *= rstd * g0.w; y[4] *= rstd * g1.x; y[5] *= rstd * g1.y; y[6] *= rstd * g1.z; y[7] *= rstd * g1.w;
                    if (lat) {
                        const int t = r & (T - 1); const float pos = ((c & 3) < 2) ? (float)(t >> 6) : (float)(t & 63);
#pragma unroll
                        for (int j = 0; j < 8; ++j) { const float yp = swz_xor<4>(y[j]); const float ang = pos * inv8[j]; const float cs = __cosf(ang), sn = __sinf(ang);
                            y[j] = (c < 4) ? (y[j] * cs - yp * sn) : (y[j] * cs + yp * sn); }
                    }
                    v4u o; o.x = cvt_pk_bf16(y[0], y[1]); o.y = cvt_pk_bf16(y[2], y[3]); o.z = cvt_pk_bf16(y[4], y[5]); o.w = cvt_pk_bf16(y[6], y[7]);
                    *(v4u*)zp = o;
                }
            }
            LAS bf16* S = (LAS bf16*)(F.lds + F.wave * 8448);
            for (int it = F.gw; it < 528 * 10; it += F.NGW) {
                const int rb = it / 10, cgp = it % 10; const bool lat = rb < 512;
                const int b = lat ? rb >> 7 : (rb - 512) >> 2, t0 = lat ? (rb & 127) * 64 : ((rb - 512) & 3) * 64;
                const int row0 = lat ? b * T + t0 : MLAT + b * CT + t0; const int pitch = lat ? T : CT;
                int col0; bf16* dst;
                if (cgp < 2) { col0 = C_VS + cgp * 64; dst = VT + (lat ? VT_VS_LAT : VT_VS_CTX) / 2 + (size_t)((b * 2 + cgp) * 64) * pitch + t0; }
                else { const int h = (cgp - 2) >> 1, dh = (cgp - 2) & 1; col0 = C_VD + h * 128 + dh * 64; dst = VT + (lat ? VT_VD_LAT : VT_VD_CTX) / 2 + (size_t)((b * 4 + h) * 128 + dh * 64) * pitch + t0; }
#pragma unroll
                for (int i = 0; i < 8; ++i) { const int tl = i * 8 + (F.lane >> 3), ch = F.lane & 7;
                    const v4u v = *(const v4u*)(Z1 + (size_t)(row0 + tl) * N1 + col0 + ch * 8);
                    LAS unsigned* sp = (LAS unsigned*)(S + tl * 66 + ch * 8); sp[0] = v.x; sp[1] = v.y; sp[2] = v.z; sp[3] = v.w; }
                asm volatile("s_waitcnt lgkmcnt(0)" ::: "memory");
#pragma unroll
                for (int i = 0; i < 8; ++i) { const int d = i * 8 + (F.lane >> 3), tc = F.lane & 7; const LAS bf16* sp = S + (tc * 8) * 66 + d;
                    v4u o; o.x = (unsigned)sp[0] | ((unsigned)sp[66] << 16); o.y = (unsigned)sp[2 * 66] | ((unsigned)sp[3 * 66] << 16);
                    o.z = (unsigned)sp[4 * 66] | ((unsigned)sp[5 * 66] << 16); o.w = (unsigned)sp[6 * 66] | ((unsigned)sp[7 * 66] << 16);
                    *(v4u*)(dst + (size_t)d * pitch + tc * 8) = o; }
                asm volatile("s_waitcnt lgkmcnt(0)" ::: "memory");
            }
            for (int rb = F.gw; rb < 2112; rb += F.NGW) {
                const bool lat = rb < 2048;
                const int b = lat ? rb >> 9 : (rb - 2048) >> 4, t0 = lat ? (rb & 511) * 16 : ((rb - 2048) & 15) * 16;
                const int s0 = lat ? b * T : MLAT + b * CT, n = lat ? T : CT;
                const int hw = 1 << (F.lane >> 4);
                const bf16* ub = Z1 + (size_t)s0 * N1 + C_U + F.lane * 8;
                float Sm[8];
#pragma unroll
                for (int e = 0; e < 8; ++e) Sm[e] = 0.f;
#define POOL_ACC(ti, sgn) do { const v4u q_ = *(const v4u*)(ub + (size_t)(ti) * N1); \
                    Sm[0] += (sgn) * bf_lo(q_.x); Sm[1] += (sgn) * bf_hi(q_.x); Sm[2] += (sgn) * bf_lo(q_.y); Sm[3] += (sgn) * bf_hi(q_.y); \
                    Sm[4] += (sgn) * bf_lo(q_.z); Sm[5] += (sgn) * bf_hi(q_.z); Sm[6] += (sgn) * bf_lo(q_.w); Sm[7] += (sgn) * bf_hi(q_.w); } while (0)
                { const int i0 = max(t0 - hw, 0), i1 = min(t0 + hw - 1, n - 1);
                  for (int i = i0; i <= i1; ++i) POOL_ACC(i, 1.0f); }
#pragma unroll 4
                for (int t = t0; t < t0 + 16; ++t) {
                    const float rc = 1.0f / (float)(min(t + hw, n) - max(t - hw, 0));
                    const v4u q = *(const v4u*)(ub + (size_t)t * N1);
                    v4u o; o.x = cvt_pk_bf16(Sm[0] * rc - bf_lo(q.x), Sm[1] * rc - bf_hi(q.x)); o.y = cvt_pk_bf16(Sm[2] * rc - bf_lo(q.y), Sm[3] * rc - bf_hi(q.y));
                    o.z = cvt_pk_bf16(Sm[4] * rc - bf_lo(q.z), Sm[5] * rc - bf_hi(q.z)); o.w = cvt_pk_bf16(Sm[6] * rc - bf_lo(q.w), Sm[7] * rc - bf_hi(q.w));
                    *(v4u*)(Y + (size_t)(s0 + t) * YW + F.lane * 8) = o;
                    if (t + hw <= n - 1) POOL_ACC(t + hw, 1.0f);
                    if (t - hw >= 0) POOL_ACC(t - hw, -1.0f);
                }
#undef POOL_ACC
            }
        }
        PH_END(true)

        PH_BEGIN
        {
            const float M2d = lamv[8 + 2 * l], M2s = lamv[8 + 2 * l + 1];
            const float lam = lamv[l], lam_init = 0.8f - 0.6f * expf(-0.3f * (float)l);
            att::UnitArgs A;
            A.zq = Z1; A.yo = Y; A.sinkl2 = 0.f; A.sink = swa_sink + l * 8; A.lam = lam; A.oscale = 1.0f - lam_init; A.subln = diff_subln + l * 128;
            const int nu = (l + 1 < NL) ? 1024 + 32 : 1024;
            for (int u = F.vcu; u < nu; u += F.G) {
                const bool lq = u < 1024; const int v = u - 1024;
                const int b = lq ? (u >> 8) : (v >> 3), h = lq ? ((u >> 6) & 3) : ((v >> 1) & 3), qb = lq ? (u & 63) : (v & 1);
                A.vt_lat = VT + VT_VD_LAT / 2 + (size_t)((b * 4 + h) * 128) * T; A.vt_ctx = VT + VT_VD_CTX / 2 + (size_t)((b * 4 + h) * 128) * CT;
                A.qgain = diff_qn + l * 64; A.qrow0 = lq ? b * T + qb * 128 : MLAT + b * CT + qb * 128; A.tq0 = lq ? qb * 128 : -1; A.krow_lat = b * T; A.krow_ctx = MLAT + b * CT;
                A.kcol = C_KD + h * 128; A.qcol0 = C_QD + h * 128; A.ycol0 = 1024 + h * 128; A.kt0 = 0; A.nlat = lq ? T / 64 : 0; A.M2 = M2d; A.hq0 = 0;
                att::attn_unit<0>(F.lds, F.tid, A);
            }
            for (int u = F.vcu; u < nu; u += F.G) {
                const bool lq = u < 1024; const int v = u - 1024;
                const int b = lq ? (u >> 8) : (v >> 3), kvh = lq ? ((u >> 7) & 1) : ((v >> 2) & 1), qb = lq ? (u & 127) : (v & 3);
                A.vt_lat = VT + VT_VS_LAT / 2 + (size_t)((b * 2 + kvh) * 64) * T; A.vt_ctx = VT + VT_VS_CTX / 2 + (size_t)((b * 2 + kvh) * 64) * CT;
                A.qgain = swa_qn + l * 64; A.qrow0 = lq ? b * T + qb * 64 : MLAT + b * CT + qb * 64; A.tq0 = lq ? qb * 64 : -1; A.krow_lat = b * T; A.krow_ctx = MLAT + b * CT;
                A.kcol = C_KS + kvh * 64; A.qcol0 = C_QS + kvh * 256; A.ycol0 = 512 + kvh * 256;
                const int k0 = max(qb - 2, 0), k1 = min(qb + 2, T / 64 - 1); A.kt0 = lq ? k0 : 0; A.nlat = lq ? k1 - k0 + 1 : 0; A.M2 = M2s; A.hq0 = kvh * 4;
                att::attn_unit<1>(F.lds, F.tid, A);
            }
        }
        PH_END(true)

        PH_BEGIN
#ifdef SG_P3A
        simple_gemm<1>(F, XN, D, 0, 0, (const bf16*)(wl + WO_G), D, MTOT, NG, D, GB, NG, nullptr, nullptr, nullptr, nullptr, nullptr);
#else
        { pg8::Gemm g{XN, (const bf16*)(wl + WO_G), MEFF, NG, D, D, D, 0, 0}; pg8::StaticOrder S; S.init(MEFF, NG, F.G, F.bx);
          pg8::EpiStore<1> E{GB, NG};
          pg8::gemm_phase<pg8::EpiStore<1>, pg8::StaticOrder, true, true>(F.lds, F.tid, g, S, E); }
#endif
        PH_END(true)

        PH_BEGIN
#ifdef SG_P3
        simple_gemm<3>(F, Y, YW, 1024, 512, (const bf16*)(wl + WO_BR), 512, MTOT, NG, 512, GB, NG, nullptr, nullptr, nullptr, nullptr, nullptr);
#else
        { pg8::Gemm g{Y, (const bf16*)(wl + WO_BR), MEFF, NG, 512, YW, 512, 4, 512}; pg8::StaticOrder S; S.init(MEFF, NG, F.G, F.bx);
          pg8::EpiGate E{GB, NG};
          pg8::gemm_phase<pg8::EpiGate, pg8::StaticOrder, true, true>(F.lds, F.tid, g, S, E); }
#endif
        PH_END(true)

        PH_BEGIN
#pragma unroll 4
        for (size_t i = (size_t)F.bx * 512 + F.tid; i < (size_t)MEFF * 128; i += (size_t)F.G * 512) {
            const size_t r = i >> 7; const int c = (int)(i & 127) * 8; const bf16* gp = GB + r * NG + c;
            const v4u a = *(const v4u*)gp, b = *(const v4u*)(gp + 1024), d = *(const v4u*)(gp + 2048);
            v4u o; o.x = cvt_pk_bf16(bf_lo(a.x) + bf_lo(b.x) + bf_lo(d.x), bf_hi(a.x) + bf_hi(b.x) + bf_hi(d.x)); o.y = cvt_pk_bf16(bf_lo(a.y) + bf_lo(b.y) + bf_lo(d.y), bf_hi(a.y) + bf_hi(b.y) + bf_hi(d.y));
            o.z = cvt_pk_bf16(bf_lo(a.z) + bf_lo(b.z) + bf_lo(d.z), bf_hi(a.z) + bf_hi(b.z) + bf_hi(d.z)); o.w = cvt_pk_bf16(bf_lo(a.w) + bf_lo(b.w) + bf_lo(d.w), bf_hi(a.w) + bf_hi(b.w) + bf_hi(d.w));
            *(v4u*)(MG + r * D + c) = o;
        }
        PH_END(true)

        PH_BEGIN
#ifdef SG_P4
        simple_gemm<4>(F, MG, D, 0, 0, (const bf16*)(wl + WO_OUT), D, MTOT, D, D, nullptr, 0, res_lat, res_ctx, out, XC, modl + 2 * 1024);
#else
        { pg8::Gemm g{MG, (const bf16*)(wl + WO_OUT), MEFF, D, D, D, D, 0, 0}; pg8::StaticOrder S; S.init(MEFF, D, F.G, F.bx);
          pg8::EpiResid E{res_lat, res_ctx, out, XC, modl + 2 * 1024};
          pg8::gemm_phase<pg8::EpiResid, pg8::StaticOrder, true, true>(F.lds, F.tid, g, S, E); }
#endif
        PH_END(true)

        PH_BEGIN
        norm_mod_rows(F, out, XC, norm2 + l * D, modl, 3, 4, XN);
        PH_END(true)

        PH_BEGIN
#ifdef SG_P5
        simple_gemm<2>(F, XN, D, 0, 0, (const bf16*)(wl + WO_1), D, MTOT, FF, D, HB, FF, nullptr, nullptr, nullptr, nullptr, nullptr);
#else
        { pg8::Gemm g{XN, (const bf16*)(wl + WO_1), MEFF, FF, D, D, D, 0, 0}; pg8::StaticOrder S; S.init(MEFF, FF, F.G, F.bx);
          pg8::EpiStore<2> E{HB, FF};
          pg8::gemm_phase<pg8::EpiStore<2>, pg8::StaticOrder, true, true>(F.lds, F.tid, g, S, E); }
#endif
        PH_END(true)

        PH_BEGIN
#ifdef SG_P6
        simple_gemm<4>(F, HB, FF, 0, 0, (const bf16*)(wl + WO_2), FF, MTOT, D, FF, nullptr, 0, out, XC, out, XC, modl + 5 * 1024);
#else
        { pg8::Gemm g{HB, (const bf16*)(wl + WO_2), MEFF, D, FF, FF, FF, 0, 0}; pg8::StaticOrder S; S.init(MEFF, D, F.G, F.bx);
          pg8::EpiResid E{out, XC, out, XC, modl + 5 * 1024};
          pg8::gemm_phase<pg8::EpiResid, pg8::StaticOrder, true, true>(F.lds, F.tid, g, S, E); }
#endif
        PH_END(l + 1 < NL)

        if (l + 1 < NL) {
            PH_BEGIN
            norm_mod_rows(F, out, XC, norm1 + (l + 1) * D, mod + (size_t)(l + 1) * 5 * 6144, 0, 1, XN);
            PH_END(true)
        }
    }
#undef PH_BEGIN
#undef PH_END
}

#undef AS4
#undef INP
#undef ws
#undef out
#undef x_in
#undef c_in
#undef ctx_in
#undef cctx_in
#undef w_ada
#undef b_ada
#undef norm1
#undef norm2
#undef w_in
#undef w_pool
#undef pool_scale
#undef swa_qn
#undef swa_kn
#undef swa_sink
#undef diff_qn
#undef diff_kn
#undef diff_lambda
#undef diff_subln
#undef w_br_pool
#undef w_br_swa
#undef w_br_diff
#undef w_out
#undef w_ff1
#undef w_ff2
#undef mod
#undef lamv
#undef XC
#undef XN
#undef Y
#undef Z1
#undef VT
#undef GB
#undef MG
#undef HB
#undef wl
#undef modl
#undef res_lat
#undef res_ctx
extern "C" void kernel_launch(void* const* d_in, const int* in_sizes, int n_in, void* d_out, int out_size, void* d_ws, size_t ws_size, hipStream_t stream) {
    static int grid = 0;
    if (grid == 0) {
        if (n_in != 24 || in_sizes[0] != MLAT * D || out_size != MLAT * D || ws_size < WS_END) {
            fprintf(stderr, "kernel_launch: unexpected shapes / workspace (n_in %d, in0 %d, out %d, ws %zu, need %zu); nothing launched\n", n_in, n_in > 0 ? in_sizes[0] : -1, out_size, ws_size, (size_t)WS_END); grid = -1; return; }
        int dev = 0, cus = 0, per_cu = 0;
        if (hipGetDevice(&dev) != hipSuccess || hipDeviceGetAttribute(&cus, hipDeviceAttributeMultiprocessorCount, dev) != hipSuccess) { grid = -1; return; }
        if (hipFuncSetAttribute((const void*)fwd_mega, hipFuncAttributeMaxDynamicSharedMemorySize, LDS_BYTES) != hipSuccess) { fprintf(stderr, "kernel_launch: hipFuncSetAttribute failed\n"); grid = -1; return; }
        if (hipOccupancyMaxActiveBlocksPerMultiprocessor(&per_cu, (const void*)fwd_mega, NWAVES * 64, LDS_BYTES) != hipSuccess || per_cu < 1) { fprintf(stderr, "kernel_launch: occupancy query says %d\n", per_cu); per_cu = 1; }
        (void)hipGetLastError();
        grid = cus * 1;
    }
    if (grid < 0) return;
    if (hipMemsetAsync((char*)d_ws + WS_CTL, 0, 1 << 20, stream) != hipSuccess) { fprintf(stderr, "kernel_launch: memset failed\n"); return; }
    Args a{};
    for (int i = 0; i < 24; ++i) a.in[i] = (const float*)d_in[i];
    a.out = (float*)d_out; a.ws = (unsigned char*)d_ws; a.ph_lo = 0; a.ph_hi = 1000;
    void* kargs[] = {&a};
    hipError_t e = hipLaunchCooperativeKernel((void*)fwd_mega, dim3(grid), dim3(NWAVES * 64), kargs, LDS_BYTES, stream);
    if (e != hipSuccess) fprintf(stderr, "cooperative launch failed: %s (grid %d)\n", hipGetErrorString(e), grid);
}
```
